# Optimizing an MI355X kernel written in HIP

```python
import math
import jax, jax.numpy as jnp
from jax import lax
import numpy as np

D_MODEL = 1024
BATCH = 2
SEQ = 16384
DEPTH = 4

CTX_LEN = 256
GRID_W = 64
N_MIXERS = 2
N_ATTN_LAYERS = (DEPTH + N_MIXERS - 1) // N_MIXERS
N_CMLP_LAYERS = DEPTH // N_MIXERS
DA_HEADS = 8
DA_QK_DIM = 64
DA_V_DIM = 2 * DA_QK_DIM
Q_BLOCK = 128
ROPE_BASE = 10000.0
ROPE_AXIS_DIM = DA_QK_DIM // 2
QKV_WIDTH = 2 * DA_HEADS * DA_QK_DIM * 2 + DA_HEADS * DA_V_DIM
CHUNK = 128
CM_WIDTH = D_MODEL
CM_GROUPS = 8
CM_GROUP_DIM = CM_WIDTH // CM_GROUPS
FFN_HIDDEN = ((math.ceil(8 * D_MODEL / 3) + 255) // 256) * 256
N_MOD = 6
EPS = 1e-6

kernel_name = 'hybrid_diffattn_chunkmlp_dit'


def rms_norm(x, g):
    xf = x.astype(jnp.float32)
    y = xf * lax.rsqrt(jnp.mean(xf * xf, axis=-1, keepdims=True) + EPS)
    return (y * g.astype(jnp.float32)).astype(x.dtype)


def layer_norm(x, g, b):
    xf = x.astype(jnp.float32)
    mu = jnp.mean(xf, axis=-1, keepdims=True)
    var = jnp.mean(jnp.square(xf - mu), axis=-1, keepdims=True)
    y = (xf - mu) * lax.rsqrt(var + EPS) * g.astype(jnp.float32) + b.astype(jnp.float32)
    return y.astype(x.dtype)


def modulate(h, shift, scale):
    return h * (1 + scale) + shift


def axial_angles(n_tokens):
    rows = n_tokens // GRID_W
    row = jnp.broadcast_to(jnp.arange(rows, dtype=jnp.float32)[:, None], (rows, GRID_W)).reshape(-1)
    col = jnp.broadcast_to(jnp.arange(GRID_W, dtype=jnp.float32)[None, :], (rows, GRID_W)).reshape(-1)
    inv_freq = ROPE_BASE ** (-jnp.arange(0, ROPE_AXIS_DIM, 2, dtype=jnp.float32) / ROPE_AXIS_DIM)
    return row[:, None] * inv_freq, col[:, None] * inv_freq


def rotate(x, ang):
    cos = jnp.cos(ang)[None, :, None, :].astype(x.dtype)
    sin = jnp.sin(ang)[None, :, None, :].astype(x.dtype)
    x1, x2 = jnp.split(x, 2, axis=-1)
    return jnp.concatenate([x1 * cos - x2 * sin, x2 * cos + x1 * sin], axis=-1)


def rope_2d(x, ang_row, ang_col):
    x_row, x_col = jnp.split(x, 2, axis=-1)
    return jnp.concatenate([rotate(x_row, ang_row), rotate(x_col, ang_col)], axis=-1)


def diff_attend(q, k, v, lam):
    b, sq, h2, dk = q.shape
    n_blk = sq // Q_BLOCK
    q_blocks = jnp.moveaxis(q.reshape(b, n_blk, Q_BLOCK, h2, dk), 1, 0)
    scale = dk ** -0.5

    def one_block(qb):
        s = jnp.einsum('bqhd,bkhd->bhqk', qb, k, preferred_element_type=jnp.float32) * scale
        p = jax.nn.softmax(s, axis=-1).reshape(b, h2 // 2, 2, Q_BLOCK, -1)
        w = (p[:, :, 0] - lam * p[:, :, 1]).astype(v.dtype)
        return jnp.einsum('bhqk,bkhe->bqhe', w, v)

    out = lax.map(one_block, q_blocks)
    return jnp.moveaxis(out, 0, 1).reshape(b, sq, h2 // 2, -1)


def diff_attention(hx, hc, j, layer_idx, ang_row, ang_col, ctx_live,
                   w_qkv, w_attn_out, lam_q1, lam_k1, lam_q2, lam_k2, g_subln):
    lam_init = 0.8 - 0.6 * math.exp(-0.3 * layer_idx)
    f32 = jnp.float32
    lam = (jnp.exp(jnp.sum(lam_q1[j].astype(f32) * lam_k1[j].astype(f32)))
           - jnp.exp(jnp.sum(lam_q2[j].astype(f32) * lam_k2[j].astype(f32))) + lam_init)
    qk_w = 2 * DA_HEADS * DA_QK_DIM

    def project(h):
        b, s, _ = h.shape
        q, k, v = jnp.split(h @ w_qkv[j], [qk_w, 2 * qk_w], axis=-1)
        return (q.reshape(b, s, 2 * DA_HEADS, DA_QK_DIM),
                k.reshape(b, s, 2 * DA_HEADS, DA_QK_DIM),
                v.reshape(b, s, DA_HEADS, DA_V_DIM))

    def finish(o):
        b, s = o.shape[:2]
        o = rms_norm(o, g_subln[j]) * (1 - lam_init)
        return o.reshape(b, s, DA_HEADS * DA_V_DIM) @ w_attn_out[j]

    qx, kx, vx = project(hx)
    qx = rope_2d(qx, ang_row, ang_col)
    kx = rope_2d(kx, ang_row, ang_col)
    qc, kc, vc = project(hc)
    k_all = jnp.concatenate([kc, kx], axis=1)
    v_all = jnp.concatenate([vc, vx], axis=1)
    yx = finish(diff_attend(qx, k_all, v_all, lam))
    yc = finish(diff_attend(qc, kc, vc, lam)) if ctx_live else None
    return yx, yc


def chunk_mlp(h, j, w_uv, b_uv, g_sgu, b_sgu, w_spatial, b_spatial, w_cmlp_out):
    b, s, _ = h.shape
    z = jax.nn.gelu(h @ w_uv[j] + b_uv[j], approximate=False)
    u, v = jnp.split(z, 2, axis=-1)
    v = layer_norm(v, g_sgu[j], b_sgu[j])
    v = v.reshape(b, s // CHUNK, CHUNK, CM_GROUPS, CM_GROUP_DIM)
    sv = (jnp.einsum('gpq,bnqge->bnpge', w_spatial[j], v)
          + b_spatial[j].T[None, None, :, :, None])
    return (u * sv.reshape(b, s, CM_WIDTH)) @ w_cmlp_out[j]


def swiglu(h, j, w_ffn_in, w_ffn_out):
    gate, up = jnp.split(h @ w_ffn_in[j], 2, axis=-1)
    return (jax.nn.silu(gate) * up) @ w_ffn_out[j]


def setup_inputs(seed: int = 0) -> dict:
    key = jax.random.key(seed)
    ks = jax.random.split(key, 26)
    nrm = jax.random.normal
    f32 = jnp.float32
    D, NA, NB, F = D_MODEL, N_ATTN_LAYERS, N_CMLP_LAYERS, FFN_HIDDEN
    return {
        'x': nrm(ks[0], (BATCH, SEQ, D), f32),
        'c': nrm(ks[1], (BATCH, D), f32),
        'ctx': nrm(ks[2], (BATCH, CTX_LEN, D), f32),
        'c_ctx': nrm(ks[3], (D,), f32),
        'w_ada': nrm(ks[4], (DEPTH, D, N_MOD * D), f32) * (0.5 * D ** -0.5),
        'b_ada': nrm(ks[5], (DEPTH, N_MOD * D), f32) * 0.01,
        'g_mix_pre': 1.0 + 0.05 * nrm(ks[6], (DEPTH, D), f32),
        'g_mix_post': 1.0 + 0.05 * nrm(ks[7], (DEPTH, D), f32),
        'g_ffn_pre': 1.0 + 0.05 * nrm(ks[8], (DEPTH, D), f32),
        'g_ffn_post': 1.0 + 0.05 * nrm(ks[9], (DEPTH, D), f32),
        'w_qkv': nrm(ks[10], (NA, D, QKV_WIDTH), f32) * D ** -0.5,
        'w_attn_out': nrm(ks[11], (NA, DA_HEADS * DA_V_DIM, D), f32) * (DA_HEADS * DA_V_DIM) ** -0.5,
        'lam_q1': 0.1 * nrm(ks[12], (NA, DA_QK_DIM), f32),
        'lam_k1': 0.1 * nrm(ks[13], (NA, DA_QK_DIM), f32),
        'lam_q2': 0.1 * nrm(ks[14], (NA, DA_QK_DIM), f32),
        'lam_k2': 0.1 * nrm(ks[15], (NA, DA_QK_DIM), f32),
        'g_subln': 1.0 + 0.05 * nrm(ks[16], (NA, DA_V_DIM), f32),
        'w_uv': nrm(ks[17], (NB, D, 2 * CM_WIDTH), f32) * D ** -0.5,
        'b_uv': 0.02 * nrm(ks[18], (NB, 2 * CM_WIDTH), f32),
        'g_sgu': 1.0 + 0.05 * nrm(ks[19], (NB, CM_WIDTH), f32),
        'b_sgu': 0.02 * nrm(ks[20], (NB, CM_WIDTH), f32),
        'w_spatial': nrm(ks[21], (NB, CM_GROUPS, CHUNK, CHUNK), f32) * (0.5 * CHUNK ** -0.5),
        'b_spatial': 1.0 + 0.1 * nrm(ks[22], (NB, CM_GROUPS, CHUNK), f32),
        'w_cmlp_out': nrm(ks[23], (NB, CM_WIDTH, D), f32) * CM_WIDTH ** -0.5,
        'w_ffn_in': nrm(ks[24], (DEPTH, D, 2 * F), f32) * D ** -0.5,
        'w_ffn_out': nrm(ks[25], (DEPTH, F, D), f32) * F ** -0.5,
    }


def reference(x, c, ctx, c_ctx, w_ada, b_ada, g_mix_pre, g_mix_post, g_ffn_pre, g_ffn_post,
              w_qkv, w_attn_out, lam_q1, lam_k1, lam_q2, lam_k2, g_subln,
              w_uv, b_uv, g_sgu, b_sgu, w_spatial, b_spatial, w_cmlp_out,
              w_ffn_in, w_ffn_out):
    ang_row, ang_col = axial_angles(x.shape[1])
    silu_c = jax.nn.silu(c)
    silu_cc = jax.nn.silu(c_ctx)
    last_attn = max(i for i in range(DEPTH) if i % N_MIXERS == 0)
    for i in range(DEPTH):
        is_attn = (i % N_MIXERS == 0)
        j = i // N_MIXERS
        ctx_live = i < last_attn
        mod_x = (silu_c @ w_ada[i] + b_ada[i])[:, None, :]
        mod_c = silu_cc @ w_ada[i] + b_ada[i]
        sh_m, sc_m, g_m, sh_f, sc_f, g_f = jnp.split(mod_x, N_MOD, axis=-1)
        csh_m, csc_m, cg_m, csh_f, csc_f, cg_f = jnp.split(mod_c, N_MOD, axis=-1)

        hx = modulate(rms_norm(x, g_mix_pre[i]), sh_m, sc_m)
        if is_attn:
            hc = modulate(rms_norm(ctx, g_mix_pre[i]), csh_m, csc_m)
            yx, yc = diff_attention(hx, hc, j, i, ang_row, ang_col, ctx_live,
                                    w_qkv, w_attn_out, lam_q1, lam_k1, lam_q2, lam_k2, g_subln)
        else:
            yx = chunk_mlp(hx, j, w_uv, b_uv, g_sgu, b_sgu, w_spatial, b_spatial, w_cmlp_out)
            if ctx_live:
                hc = modulate(rms_norm(ctx, g_mix_pre[i]), csh_m, csc_m)
                yc = chunk_mlp(hc, j, w_uv, b_uv, g_sgu, b_sgu, w_spatial, b_spatial, w_cmlp_out)
        x = x + g_m * rms_norm(yx, g_mix_post[i])
        fx = swiglu(modulate(rms_norm(x, g_ffn_pre[i]), sh_f, sc_f), i, w_ffn_in, w_ffn_out)
        x = x + g_f * rms_norm(fx, g_ffn_post[i])

        if ctx_live:
            ctx = ctx + cg_m * rms_norm(yc, g_mix_post[i])
            fc = swiglu(modulate(rms_norm(ctx, g_ffn_pre[i]), csh_f, csc_f), i, w_ffn_in, w_ffn_out)
            ctx = ctx + cg_f * rms_norm(fc, g_ffn_post[i])
    return x
```

```cpp
#include <hip/hip_runtime.h>
#include <hip/hip_bf16.h>
#include <hip/hip_cooperative_groups.h>
#include <cstdio>
#include <cstdint>
namespace cg = cooperative_groups;

#ifndef SINGLE_LAUNCH
#define SINGLE_LAUNCH 1
#endif

using bf16 = __hip_bfloat16;
using bf16x8 = __attribute__((ext_vector_type(8))) short;
using s16x4  = __attribute__((ext_vector_type(4))) short;
using f32x16 = __attribute__((ext_vector_type(16))) float;
using f32x4  = __attribute__((ext_vector_type(4))) float;
using u32x4  = __attribute__((ext_vector_type(4))) unsigned;
using u32x2  = __attribute__((ext_vector_type(2))) unsigned;
#define DI __device__ __forceinline__

constexpr int DM = 1024, NBATCH = 2, SEQ = 16384, CTXL = 256;
constexpr int NLAT = NBATCH * SEQ, NCTX = NBATCH * CTXL, NROWS = NLAT + NCTX;
constexpr int FH = 2816, QKVW = 3072, NMOD = 6;
constexpr int NTHR = 512;
constexpr float EPS = 1e-6f;

constexpr size_t SZ_WQKV = 2ull * 3072 * 1024 * 2, SZ_WAO = 2ull * 1024 * 1024 * 2, SZ_WUV = 2ull * 2048 * 1024 * 2, SZ_WCO = 2ull * 1024 * 1024 * 2;
constexpr size_t SZ_WFI = 4ull * 5632 * 1024 * 2, SZ_WFO = 4ull * 1024 * 2816 * 2, SZ_WSP = 2ull * 8 * 128 * 128 * 2;
constexpr size_t SZ_MODS = 4ull * 3 * 6144 * 4, SZ_ROPE = 256ull * 16 * 2 * 4, SZ_XCTX = 512ull * 1024 * 4;
constexpr size_t SZ_H = (size_t)NROWS * 1024 * 2, SZ_A = (size_t)NROWS * 3072 * 2, SZ_B = (size_t)NROWS * 2048 * 2;
constexpr size_t OFF_WQKV = 0, OFF_WAO = OFF_WQKV + SZ_WQKV, OFF_WUV = OFF_WAO + SZ_WAO, OFF_WCO = OFF_WUV + SZ_WUV, OFF_WFI = OFF_WCO + SZ_WCO,
                 OFF_WFO = OFF_WFI + SZ_WFI, OFF_WSP = OFF_WFO + SZ_WFO, OFF_MODS = OFF_WSP + SZ_WSP, OFF_ROPE = OFF_MODS + SZ_MODS,
                 OFF_XCTX = OFF_ROPE + SZ_ROPE, OFF_H = OFF_XCTX + SZ_XCTX, OFF_A = OFF_H + SZ_H, OFF_B = OFF_A + SZ_A, OFF_BAR = OFF_B + SZ_B, WS_END = OFF_BAR + 16384;

struct Params {
  const float *x, *c, *ctx, *c_ctx, *w_ada, *b_ada, *g_mix_pre, *g_mix_post, *g_ffn_pre, *g_ffn_post,
      *w_qkv, *w_attn_out, *lam_q1, *lam_k1, *lam_q2, *lam_k2, *g_subln,
      *w_uv, *b_uv, *g_sgu, *b_sgu, *w_spatial, *b_spatial, *w_cmlp_out, *w_ffn_in, *w_ffn_out;
  float* out; char* ws;
};

DI unsigned cvtpk(float lo, float hi) { unsigned r; asm volatile("v_cvt_pk_bf16_f32 %0, %1, %2" : "=v"(r) : "v"(lo), "v"(hi)); return r; }
DI float bf_lo(unsigned u) { return __uint_as_float(u << 16); }
DI float bf_hi(unsigned u) { return __uint_as_float(u & 0xffff0000u); }
template <int M> DI float swz_xor(float v) { return __int_as_float(__builtin_amdgcn_ds_swizzle(__float_as_int(v), 0x1f | (M << 10))); }
DI float wave_sum(float v) {
  v += swz_xor<16>(v); v += swz_xor<8>(v); v += swz_xor<4>(v); v += swz_xor<2>(v); v += swz_xor<1>(v);
  auto rr = __builtin_amdgcn_permlane32_swap(__float_as_uint(v), __float_as_uint(v), false, false);
  return __uint_as_float(rr[0]) + __uint_as_float(rr[1]);
}
DI unsigned otid() { unsigned t = threadIdx.x; asm volatile("" : "+v"(t)); return t; }
using f32x2 = __attribute__((ext_vector_type(2))) float;
DI f32x2 gelu_pk(f32x2 v) {
  const f32x2 av = __builtin_elementwise_abs(v), d = av * 0.2316418882f + 1.0f;
  f32x2 t; t.x = __builtin_amdgcn_rcpf(d.x); t.y = __builtin_amdgcn_rcpf(d.y);
  f32x2 q = t * 0.5307027145f + (-0.7265760135f); q = q * t + 0.7107068705f; q = q * t + (-0.142248368f); q = q * t + 0.127414796f; q = q * t;
  const f32x2 s = (v * v) * (-0.72134752044f);
  f32x2 e; e.x = __builtin_amdgcn_exp2f(s.x); e.y = __builtin_amdgcn_exp2f(s.y);
  const f32x2 m = v * (q * e), r = v - m;
  f32x2 o; o.x = v.x < 0.f ? m.x : r.x; o.y = v.y < 0.f ? m.y : r.y; return o;
}
DI float silu_f(float v) { return v * __builtin_amdgcn_rcpf(1.f + __builtin_amdgcn_exp2f(-1.4426950408889634f * v)); }
DI float* xres(const Params& p, int row) { return row < NLAT ? p.out + (size_t)row * DM : (float*)(p.ws + OFF_XCTX) + (size_t)(row - NLAT) * DM; }
DI int modvec(int row) { return row < SEQ ? 0 : (row < NLAT ? 1 : 2); }

constexpr int NI_MODS = 4 * 96;
constexpr int T_QKV = 16 * 48, T_AO = 16 * 16, T_UV = 16 * 32, T_CO = 16 * 16, T_FI = 16 * 88, T_FO = 44 * 16;
constexpr int NI_TR = 2 * T_QKV + 2 * T_AO + 2 * T_UV + 2 * T_CO + 4 * T_FI + 4 * T_FO;
constexpr int NI_SP = 64;
constexpr int NI_P0 = NI_MODS + NI_TR + NI_SP + 1;

DI void tr_tile(const float* __restrict__ src, bf16* __restrict__ dst, int K, int N, int tk, int tn, int perm, unsigned* lds) {
  const int t = (int)otid();
  const int k0 = tk * 64, n0 = tn * 64;
  {
    const int kp = t >> 4, nn = (t & 15) * 4;
    const float4 a = *reinterpret_cast<const float4*>(src + (size_t)(k0 + 2 * kp) * N + n0 + nn);
    const float4 b = *reinterpret_cast<const float4*>(src + (size_t)(k0 + 2 * kp + 1) * N + n0 + nn);
    lds[(nn + 0) * 33 + kp] = cvtpk(a.x, b.x);
    lds[(nn + 1) * 33 + kp] = cvtpk(a.y, b.y);
    lds[(nn + 2) * 33 + kp] = cvtpk(a.z, b.z);
    lds[(nn + 3) * 33 + kp] = cvtpk(a.w, b.w);
  }
  __syncthreads();
  {
    const int n = t >> 3, k4 = (t & 7) * 4;
    u32x4 v = {lds[n * 33 + k4], lds[n * 33 + k4 + 1], lds[n * 33 + k4 + 2], lds[n * 33 + k4 + 3]};
    int c = n0 + n, drow = c;
    if (perm == 1) { const int nsel = c >= FH ? 1 : 0; const int j = c - nsel * FH; drow = (j >> 4) * 32 + nsel * 16 + (j & 15); }
    else if (perm == 2 || (perm == 3 && c >= 2048)) drow = (c & ~31) | ((c & 1) << 4) | ((c & 31) >> 1);
    *reinterpret_cast<u32x4*>(dst + (size_t)drow * K + k0 + k4 * 2) = v;
  }
  __syncthreads();
}

DI void phase_prologue(const Params& p, char* ldsc) {
  unsigned* lds = (unsigned*)ldsc;
  float* ldsf = (float*)ldsc;
  const int t = (int)otid(), wid = t >> 6, lane = t & 63;
  for (int it = blockIdx.x; it < NI_P0; it += gridDim.x) {
    if (it < NI_MODS) {
      const int layer = it / 96, cb = it % 96;
      for (int i = t; i < 3 * 1024; i += NTHR) {
        const int v = i >> 10, k = i & 1023;
        const float cv = v < 2 ? p.c[v * 1024 + k] : p.c_ctx[k];
        ldsf[i] = silu_f(cv);
      }
      __syncthreads();
      const float* w = p.w_ada + (size_t)layer * 1024 * 6144 + cb * 64 + lane;
      float a0 = 0.f, a1 = 0.f, a2 = 0.f;
      const int kb = wid * 128;
#pragma unroll 8
      for (int k = 0; k < 128; ++k) {
        const float wv = w[(size_t)(kb + k) * 6144];
        a0 = fmaf(ldsf[kb + k], wv, a0); a1 = fmaf(ldsf[1024 + kb + k], wv, a1); a2 = fmaf(ldsf[2048 + kb + k], wv, a2);
      }
      __syncthreads();
      ldsf[3072 + (wid * 3 + 0) * 64 + lane] = a0; ldsf[3072 + (wid * 3 + 1) * 64 + lane] = a1; ldsf[3072 + (wid * 3 + 2) * 64 + lane] = a2;
      __syncthreads();
      if (t < 192) {
        const int v = t >> 6, cl = t & 63;
        float s = 0.f;
#pragma unroll
        for (int w8 = 0; w8 < 8; ++w8) s += ldsf[3072 + (w8 * 3 + v) * 64 + cl];
        const int col = cb * 64 + cl;
        ((float*)(p.ws + OFF_MODS))[(size_t)(layer * 3 + v) * 6144 + col] = s + p.b_ada[layer * 6144 + col];
      }
      __syncthreads();
    } else if (it < NI_MODS + NI_TR) {
      int r = it - NI_MODS;
      const float* src; bf16* dst; int K, N, tn_cnt; int perm = 2;
      if (r < 2 * T_QKV) { const int j = r / T_QKV; r %= T_QKV; K = 1024; N = 3072; src = p.w_qkv + (size_t)j * K * N; dst = (bf16*)(p.ws + OFF_WQKV) + (size_t)j * K * N; perm = 3; }
      else if ((r -= 2 * T_QKV) < 2 * T_AO) { const int j = r / T_AO; r %= T_AO; K = 1024; N = 1024; src = p.w_attn_out + (size_t)j * K * N; dst = (bf16*)(p.ws + OFF_WAO) + (size_t)j * K * N; }
      else if ((r -= 2 * T_AO) < 2 * T_UV) { const int j = r / T_UV; r %= T_UV; K = 1024; N = 2048; src = p.w_uv + (size_t)j * K * N; dst = (bf16*)(p.ws + OFF_WUV) + (size_t)j * K * N; }
      else if ((r -= 2 * T_UV) < 2 * T_CO) { const int j = r / T_CO; r %= T_CO; K = 1024; N = 1024; src = p.w_cmlp_out + (size_t)j * K * N; dst = (bf16*)(p.ws + OFF_WCO) + (size_t)j * K * N; }
      else if ((r -= 2 * T_CO) < 4 * T_FI) { const int j = r / T_FI; r %= T_FI; K = 1024; N = 5632; src = p.w_ffn_in + (size_t)j * K * N; dst = (bf16*)(p.ws + OFF_WFI) + (size_t)j * K * N; perm = 1; }
      else { r -= 4 * T_FI; const int j = r / T_FO; r %= T_FO; K = 2816; N = 1024; src = p.w_ffn_out + (size_t)j * K * N; dst = (bf16*)(p.ws + OFF_WFO) + (size_t)j * K * N; }
      tn_cnt = N / 64;
      tr_tile(src, dst, K, N, r / tn_cnt, r % tn_cnt, perm, lds);
    } else if (it < NI_MODS + NI_TR + NI_SP) {
      const int r = it - NI_MODS - NI_TR;
      const size_t e = (size_t)r * 4096 + t * 8;
      const float4 a = *reinterpret_cast<const float4*>(p.w_spatial + e), b = *reinterpret_cast<const float4*>(p.w_spatial + e + 4);
      u32x4 v = {cvtpk(a.x, a.y), cvtpk(a.z, a.w), cvtpk(b.x, b.y), cvtpk(b.z, b.w)};
      *reinterpret_cast<u32x4*>((bf16*)(p.ws + OFF_WSP) + e) = v;
    } else {
      float2* tab = (float2*)(p.ws + OFF_ROPE);
      for (int i = t; i < 4096; i += NTHR) {
        const int pos = i >> 4, f = i & 15;
        const float inv = powf(10000.f, -(float)(2 * f) / 32.f);
        const float ang = (float)pos * inv;
        tab[i] = make_float2(cosf(ang), sinf(ang));
      }
    }
  }
}

template <bool FIRST, int R>
DI void rowwise_batch(bool src_in, const Params& p, int row0, int lane, const bf16* __restrict__ ybr, int lb, int gate_off, const float* __restrict__ g_post,
                      bool write_h, const float* __restrict__ g_pre, int lh, int sh_off, int sc_off) {
  const float* mods = (const float*)(p.ws + OFF_MODS);
  bf16* H = (bf16*)(p.ws + OFF_H);
  const int mv = modvec(row0);
  float4 xv[R][4]; u32x2 yv[R][4];
#pragma unroll
  for (int r = 0; r < R; ++r) {
    const int row = row0 + r;
    const float* xin = (FIRST || src_in) ? (row < NLAT ? p.x + (size_t)row * DM : p.ctx + (size_t)(row - NLAT) * DM) : xres(p, row);
#pragma unroll
    for (int i = 0; i < 4; ++i) { const f32x4 t_ = __builtin_nontemporal_load(reinterpret_cast<const f32x4*>(xin + lane * 4 + 256 * i)); xv[r][i] = make_float4(t_[0], t_[1], t_[2], t_[3]); }
    if (!FIRST) {
#pragma unroll
      for (int i = 0; i < 4; ++i) yv[r][i] = __builtin_nontemporal_load(reinterpret_cast<const u32x2*>(ybr + (size_t)row * DM + lane * 4 + 256 * i));
    }
  }
  if (!FIRST) {
    const float* gate = mods + (size_t)(lb * 3 + mv) * 6144 + gate_off;
    float4 gg[4];
#pragma unroll
    for (int i = 0; i < 4; ++i) {
      const int col = lane * 4 + 256 * i;
      const float4 gt = *reinterpret_cast<const float4*>(gate + col), gp = *reinterpret_cast<const float4*>(g_post + col);
      gg[i] = make_float4(gt.x * gp.x, gt.y * gp.y, gt.z * gp.z, gt.w * gp.w);
    }
#pragma unroll
    for (int r = 0; r < R; ++r) {
      float yf[4][4];
      float ss = 0.f;
#pragma unroll
      for (int i = 0; i < 4; ++i) {
        yf[i][0] = bf_lo(yv[r][i][0]); yf[i][1] = bf_hi(yv[r][i][0]); yf[i][2] = bf_lo(yv[r][i][1]); yf[i][3] = bf_hi(yv[r][i][1]);
        ss += yf[i][0] * yf[i][0] + yf[i][1] * yf[i][1] + yf[i][2] * yf[i][2] + yf[i][3] * yf[i][3];
      }
      ss = wave_sum(ss);
      const float rstd = rsqrtf(ss * (1.f / DM) + EPS);
#pragma unroll
      for (int i = 0; i < 4; ++i) {
        xv[r][i].x += gg[i].x * (yf[i][0] * rstd); xv[r][i].y += gg[i].y * (yf[i][1] * rstd);
        xv[r][i].z += gg[i].z * (yf[i][2] * rstd); xv[r][i].w += gg[i].w * (yf[i][3] * rstd);
      }
    }
  }
  if (!FIRST)
#pragma unroll
  for (int r = 0; r < R; ++r) {
    float* xr = xres(p, row0 + r);
#pragma unroll
    for (int i = 0; i < 4; ++i) { const f32x4 t_ = {xv[r][i].x, xv[r][i].y, xv[r][i].z, xv[r][i].w}; __builtin_nontemporal_store(t_, reinterpret_cast<f32x4*>(xr + lane * 4 + 256 * i)); }
  }
  if (write_h) {
    const float* sh = mods + (size_t)(lh * 3 + mv) * 6144 + sh_off;
    const float* sc = mods + (size_t)(lh * 3 + mv) * 6144 + sc_off;
    float4 ga[4], sb[4];
#pragma unroll
    for (int i = 0; i < 4; ++i) {
      const int col = lane * 4 + 256 * i;
      const float4 g = *reinterpret_cast<const float4*>(g_pre + col), s2 = *reinterpret_cast<const float4*>(sc + col);
      sb[i] = *reinterpret_cast<const float4*>(sh + col);
      ga[i] = make_float4(g.x * (1.f + s2.x), g.y * (1.f + s2.y), g.z * (1.f + s2.z), g.w * (1.f + s2.w));
    }
#pragma unroll
    for (int r = 0; r < R; ++r) {
      float ss = 0.f;
#pragma unroll
      for (int i = 0; i < 4; ++i) ss += xv[r][i].x * xv[r][i].x + xv[r][i].y * xv[r][i].y + xv[r][i].z * xv[r][i].z + xv[r][i].w * xv[r][i].w;
      ss = wave_sum(ss);
      const float rstd = rsqrtf(ss * (1.f / DM) + EPS);
#pragma unroll
      for (int i = 0; i < 4; ++i) {
        const int col = lane * 4 + 256 * i;
        const float h0 = xv[r][i].x * rstd * ga[i].x + sb[i].x, h1 = xv[r][i].y * rstd * ga[i].y + sb[i].y;
        const float h2 = xv[r][i].z * rstd * ga[i].z + sb[i].z, h3 = xv[r][i].w * rstd * ga[i].w + sb[i].w;
        u32x2 o = {cvtpk(h0, h1), cvtpk(h2, h3)};
        *reinterpret_cast<u32x2*>(H + (size_t)(row0 + r) * DM + col) = o;
      }
    }
  }
}
template <bool FIRST>
DI void phase_rowwise(bool src_in, const Params& p, int nrows, const bf16* __restrict__ ybr, int lb, int gate_off, const float* __restrict__ g_post,
                      bool write_h, const float* __restrict__ g_pre, int lh, int sh_off, int sc_off) {
  const int t_ = (int)otid(); const int wid = t_ >> 6, lane = t_ & 63;
  for (int g = blockIdx.x * 8 + wid; g < NLAT / 4; g += gridDim.x * 8)
    rowwise_batch<FIRST, 4>(src_in, p, g * 4, lane, ybr, lb, gate_off, g_post, write_h, g_pre, lh, sh_off, sc_off);
  for (int row = NLAT + blockIdx.x * 8 + wid; row < nrows; row += gridDim.x * 8)
    rowwise_batch<FIRST, 1>(src_in, p, row, lane, ybr, lb, gate_off, g_post, write_h, g_pre, lh, sh_off, sc_off);
}

DI void phase_attn_finish(const Params& p, int nrows, int j, float lam_init) {
  const int t_ = (int)otid(); const int wid = t_ >> 6, lane = t_ & 63;
  float d1 = p.lam_q1[j * 64 + lane] * p.lam_k1[j * 64 + lane], d2 = p.lam_q2[j * 64 + lane] * p.lam_k2[j * 64 + lane];
  d1 = wave_sum(d1); d2 = wave_sum(d2);
  const float lam = __expf(d1) - __expf(d2) + lam_init;
  const bf16* O16 = (const bf16*)(p.ws + OFF_B);
  bf16* Aout = (bf16*)(p.ws + OFF_H);
  const int h = lane >> 3, e0 = (lane & 7) * 16;
  float gs[16];
#pragma unroll
  for (int i = 0; i < 16; ++i) gs[i] = p.g_subln[j * 128 + e0 + i] * (1.f - lam_init);
  for (int row = blockIdx.x * 8 + wid; row < nrows; row += gridDim.x * 8) {
    const bf16* o0 = O16 + (size_t)row * 2048 + (2 * h) * 128 + e0;
    const u32x4 a0 = *reinterpret_cast<const u32x4*>(o0), a1 = *reinterpret_cast<const u32x4*>(o0 + 8);
    const u32x4 b0 = *reinterpret_cast<const u32x4*>(o0 + 128), b1 = *reinterpret_cast<const u32x4*>(o0 + 136);
    float v[16];
#pragma unroll
    for (int i = 0; i < 4; ++i) {
      v[2 * i] = bf_lo(a0[i]) - lam * bf_lo(b0[i]); v[2 * i + 1] = bf_hi(a0[i]) - lam * bf_hi(b0[i]);
      v[8 + 2 * i] = bf_lo(a1[i]) - lam * bf_lo(b1[i]); v[8 + 2 * i + 1] = bf_hi(a1[i]) - lam * bf_hi(b1[i]);
    }
    float ss = 0.f;
#pragma unroll
    for (int i = 0; i < 16; ++i) ss += v[i] * v[i];
    ss += swz_xor<1>(ss); ss += swz_xor<2>(ss); ss += swz_xor<4>(ss);
    const float rstd = rsqrtf(ss * (1.f / 128.f) + EPS);
    u32x4 w0, w1;
#pragma unroll
    for (int i = 0; i < 4; ++i) {
      w0[i] = cvtpk(v[2 * i] * rstd * gs[2 * i], v[2 * i + 1] * rstd * gs[2 * i + 1]);
      w1[i] = cvtpk(v[8 + 2 * i] * rstd * gs[8 + 2 * i], v[8 + 2 * i + 1] * rstd * gs[8 + 2 * i + 1]);
    }
    bf16* dst = Aout + (size_t)row * DM + h * 128 + e0;
    *reinterpret_cast<u32x4*>(dst) = w0; *reinterpret_cast<u32x4*>(dst + 8) = w1;
  }
}

constexpr int BM = 256, BK = 64, HALF = 128, HT = HALF * BK, SHM_GEMM = 8 * HT * 2;
DI int lds_byte(int r, int c) { int st = (r >> 4) * 2 + (c >> 5), rr = r & 15, cc = c & 31, ob = rr * 64 + cc * 2; return st * 1024 + (ob ^ (((ob >> 9) & 1) << 5)); }
DI void stage_rc(int b, int& R, int& C) { int st = b / 1024, sb = b % 1024, swz = sb ^ (((sb >> 9) & 1) << 5); R = (st >> 1) * 16 + swz / 64; C = (st & 1) * 32 + (swz % 64) / 2; }

struct EpiArgs { bf16* out; int ldo; const float* aux; const float2* rope; };

constexpr int EPI_STORE = 0, EPI_ROPE = 1, EPI_SWIGLU = 2, EPI_GELU = 3;
constexpr float QSCALE = 0.125f * 1.4426950408889634f;

template <int EPI>
DI void gemm_epilogue(f32x4 (&acc)[2][2][4][2], const EpiArgs& ea, int brow, int bcol, bool quad) {
  const unsigned tid = otid();
  const int wid = tid >> 6, lane = tid & 63, wr = wid >> 2, wc = wid & 3, fr = lane & 15, fq = lane >> 4;
  const int ldo = ea.ldo;
  const int ocol0 = (EPI == EPI_SWIGLU) ? (bcol >> 1) : bcol;
  bf16* obase = ea.out + (size_t)brow * ldo + ocol0;
  const unsigned tro = (unsigned)((wr * 64 + fq * 4) * ldo + ((EPI == EPI_SWIGLU) ? wc * 16 + fr : wc * 32 + 2 * fr));
  float bia[2][2];
  if constexpr (EPI == EPI_GELU) {
#pragma unroll
    for (int bj = 0; bj < 2; ++bj)
#pragma unroll
      for (int n = 0; n < 2; ++n) bia[bj][n] = ea.aux[bcol + bj * HALF + wc * 32 + 2 * fr + n];
  }
  const bool do_rope = (EPI == EPI_ROPE) && bcol < 2048 && brow < NLAT;
  const int axis = wc & 1;
  float2 csr[2] = {make_float2(1.f, 0.f), make_float2(1.f, 0.f)};
  float2 csc[4][4];
  if constexpr (EPI == EPI_ROPE) {
#pragma unroll
    for (int m = 0; m < 4; ++m)
#pragma unroll
      for (int j = 0; j < 4; ++j) csc[m][j] = make_float2(1.f, 0.f);
    if (do_rope) {
      if (axis) {
#pragma unroll
        for (int m = 0; m < 4; ++m)
#pragma unroll
          for (int j = 0; j < 4; ++j) csc[m][j] = ea.rope[((m * 16 + fq * 4 + j) & 63) * 16 + fr];
      } else {
#pragma unroll
        for (int ai = 0; ai < 2; ++ai) csr[ai] = ea.rope[(((brow & (SEQ - 1)) >> 6) + ai * 2 + wr) * 16 + fr];
      }
    }
  }
#pragma unroll
  for (int ai = 0; ai < 2; ++ai)
#pragma unroll
    for (int m = 0; m < 4; ++m)
#pragma unroll
      for (int j = 0; j < 4; ++j) {
        if (quad && ai) continue;
        bf16* rp = obase + (size_t)(ai * HALF + m * 16 + j) * ldo;
        float2 cs = make_float2(1.f, 0.f);
        if constexpr (EPI == EPI_ROPE) cs = axis ? csc[m][j] : csr[ai];
#pragma unroll
        for (int bj = 0; bj < 2; ++bj) {
          if (quad && bj) continue;
          float v0 = acc[ai][bj][m][0][j], v1 = acc[ai][bj][m][1][j];
          if constexpr (EPI == EPI_STORE) {
            *reinterpret_cast<unsigned*>(rp + tro + bj * HALF) = cvtpk(v0, v1);
          } else if constexpr (EPI == EPI_ROPE) {
            const float o0 = v0 * cs.x - v1 * cs.y, o1 = v1 * cs.x + v0 * cs.y;
            const float qs = (bcol < 1024) ? QSCALE : 1.f;
            *reinterpret_cast<unsigned*>(rp + tro + bj * HALF) = cvtpk(o0 * qs, o1 * qs);
          } else if constexpr (EPI == EPI_SWIGLU) {
            rp[tro + bj * (HALF / 2)] = __float2bfloat16(silu_f(v0) * v1);
          } else {
            v0 += bia[bj][0]; v1 += bia[bj][1];
            { const f32x2 g_ = gelu_pk((f32x2){v0, v1}); v0 = g_.x; v1 = g_.y; }
            *reinterpret_cast<unsigned*>(rp + tro + bj * HALF) = cvtpk(v0, v1);
          }
        }
      }
}

DI void gemm_phase(int epi, const bf16* __restrict__ A, const bf16* __restrict__ Bt, int Mtiles, int N, int K, int nquads, EpiArgs ea, char* ldsc) {
  bf16* shm = (bf16*)ldsc;
#define SA(b, h) (shm + ((b) * 2 + (h)) * HT)
#define SB(b, h) (shm + (4 + (b) * 2 + (h)) * HT)
#define STAGE(P, BASE, br, kt) do { const char* _g = (const char*)((BASE) + (size_t)(br) * K + (size_t)(kt) * BK); \
    __builtin_amdgcn_global_load_lds((const unsigned*)(_g + tbyte), (__attribute__((address_space(3))) unsigned*)((char*)(P) + wbase), 16, 0, 0); \
    __builtin_amdgcn_global_load_lds((const unsigned*)(_g + (size_t)128 * K + tbyte), (__attribute__((address_space(3))) unsigned*)((char*)(P) + wbase + 8192), 16, 0, 0); } while (0)
#define LDA(dst, b, h) _Pragma("unroll") for (int m = 0; m < 4; ++m) _Pragma("unroll") for (int k = 0; k < 2; ++k) \
    dst[m][k] = *reinterpret_cast<const bf16x8*>((char*)SA(b, h) + lds_byte(wr * 64 + m * 16 + fr, k * 32 + fq * 8))
#define LDB(dst, b, h) _Pragma("unroll") for (int n = 0; n < 2; ++n) _Pragma("unroll") for (int k = 0; k < 2; ++k) \
    dst[n][k] = *reinterpret_cast<const bf16x8*>((char*)SB(b, h) + lds_byte(wc * 32 + n * 16 + fr, k * 32 + fq * 8))
#define MMA(ai, bj, At_, Bt_) do { __builtin_amdgcn_s_setprio(1); \
    _Pragma("unroll") for (int m = 0; m < 4; ++m) _Pragma("unroll") for (int n = 0; n < 2; ++n) _Pragma("unroll") for (int k = 0; k < 2; ++k) \
      acc[ai][bj][m][n] = __builtin_amdgcn_mfma_f32_16x16x32_bf16(At_[m][k], Bt_[n][k], acc[ai][bj][m][n], 0, 0, 0); \
    __builtin_amdgcn_s_setprio(0); } while (0)
#define WAIT_V(n) asm volatile("s_waitcnt vmcnt(" #n ")" ::: "memory")
#define WAIT_L(n) asm volatile("s_waitcnt lgkmcnt(" #n ")" ::: "memory")
#define BAR __builtin_amdgcn_s_barrier()
#define SCHED __builtin_amdgcn_sched_barrier(0)
  const int nN = N / BM, nwg = Mtiles * nN;
  const int nt = K / BK;
  for (int tile = blockIdx.x; tile < nwg + nquads; tile += gridDim.x) {
    const unsigned tid = otid();
    const int wid = __builtin_amdgcn_readfirstlane(tid >> 6), lane = tid & 63, wr = wid >> 2, wc = wid & 3, fr = lane & 15, fq = lane >> 4;
    const unsigned wbase = (unsigned)wid * 1024u;
    unsigned tbyte;
    { int r_, c_; stage_rc((int)(tid * 16), r_, c_); tbyte = (unsigned)(r_ * K + c_) * 2u; }
    const bool quad = tile >= nwg;
    int brow, bcol;
    if (!quad) {
      int wgid = tile;
      { const int q = nwg / 8, r = nwg % 8, xcd = wgid % 8, off = wgid / 8; wgid = (xcd < r ? xcd * (q + 1) : r * (q + 1) + (xcd - r) * q) + off; }
      const int nig = 16 * nN, gid = wgid / nig, fm = gid * 16, gsz = min(Mtiles - fm, 16);
      const int pm = fm + ((wgid % nig) % gsz), pn = (wgid % nig) / gsz;
      brow = __builtin_amdgcn_readfirstlane(pm * BM); bcol = __builtin_amdgcn_readfirstlane(pn * BM);
    } else {
      const int qt = tile - nwg;
      brow = __builtin_amdgcn_readfirstlane(Mtiles * BM + (qt & 3) * HALF); bcol = __builtin_amdgcn_readfirstlane((qt >> 2) * HALF);
    }
    f32x4 acc[2][2][4][2];
#pragma unroll
    for (int a = 0; a < 2; ++a)
#pragma unroll
      for (int b = 0; b < 2; ++b)
#pragma unroll
        for (int m = 0; m < 4; ++m)
#pragma unroll
          for (int n = 0; n < 2; ++n) acc[a][b][m][n] = f32x4{0.f, 0.f, 0.f, 0.f};
    bf16x8 At[4][2], B0[2][2], B1[2][2];
    if (quad) {
#define QSTAGE(s_, kt_) do { STAGE(shm + (s_) * HT, A, brow, kt_); STAGE(shm + (4 + (s_)) * HT, Bt, bcol, kt_); } while (0)
      WAIT_V(0);
      QSTAGE(0, 0); QSTAGE(1, 1); QSTAGE(2, 2);
      for (int kt = 0; kt < nt; ++kt) {
        const int sl = kt & 3;
        if (kt + 3 < nt) { QSTAGE((kt + 3) & 3, kt + 3); WAIT_V(12); }
        else if (kt + 2 < nt) WAIT_V(8);
        else if (kt + 1 < nt) WAIT_V(4);
        else WAIT_V(0);
        BAR;
#pragma unroll
        for (int m = 0; m < 4; ++m)
#pragma unroll
          for (int k = 0; k < 2; ++k) At[m][k] = *reinterpret_cast<const bf16x8*>((char*)(shm + sl * HT) + lds_byte(wr * 64 + m * 16 + fr, k * 32 + fq * 8));
#pragma unroll
        for (int n = 0; n < 2; ++n)
#pragma unroll
          for (int k = 0; k < 2; ++k) B0[n][k] = *reinterpret_cast<const bf16x8*>((char*)(shm + (4 + sl) * HT) + lds_byte(wc * 32 + n * 16 + fr, k * 32 + fq * 8));
        WAIT_L(0); MMA(0, 0, At, B0);
        BAR;
      }
#undef QSTAGE
    } else {
    STAGE(SB(0, 0), Bt, bcol, 0); STAGE(SA(0, 0), A, brow, 0);
    STAGE(SB(0, 1), Bt, bcol + HALF, 0); STAGE(SA(0, 1), A, brow + HALF, 0);
    if (wr == 1) BAR;
    WAIT_V(4); BAR;
    STAGE(SB(1, 0), Bt, bcol, 1); STAGE(SA(1, 0), A, brow, 1); STAGE(SB(1, 1), Bt, bcol + HALF, 1);
    WAIT_V(6); BAR;
    for (int t = 0; t < nt - 2; t += 2) {
      LDB(B0, 0, 0); SCHED; LDA(At, 0, 0); STAGE(SA(1, 1), A, brow + HALF, t + 1);
      WAIT_L(8); BAR; WAIT_L(0); MMA(0, 0, At, B0); BAR; SCHED;
      LDB(B1, 0, 1); STAGE(SB(0, 0), Bt, bcol, t + 2);
      BAR; WAIT_L(0); MMA(0, 1, At, B1); BAR;
      LDA(At, 0, 1); STAGE(SA(0, 0), A, brow, t + 2);
      BAR; WAIT_L(0); MMA(1, 0, At, B0); BAR; SCHED;
      STAGE(SB(0, 1), Bt, bcol + HALF, t + 2);
      WAIT_V(6); BAR; MMA(1, 1, At, B1); BAR;
      LDB(B0, 1, 0); SCHED; LDA(At, 1, 0); STAGE(SA(0, 1), A, brow + HALF, t + 2);
      WAIT_L(8); BAR; WAIT_L(0); MMA(0, 0, At, B0); BAR; SCHED;
      LDB(B1, 1, 1); STAGE(SB(1, 0), Bt, bcol, t + 3);
      BAR; WAIT_L(0); MMA(0, 1, At, B1); BAR;
      LDA(At, 1, 1); STAGE(SA(1, 0), A, brow, t + 3);
      BAR; WAIT_L(0); MMA(1, 0, At, B0); BAR; SCHED;
      STAGE(SB(1, 1), Bt, bcol + HALF, t + 3);
      WAIT_V(6); BAR; MMA(1, 1, At, B1); BAR;
    }
    { LDB(B0, 0, 0); LDA(At, 0, 0); STAGE(SA(1, 1), A, brow + HALF, nt - 1);
      BAR; WAIT_L(0); MMA(0, 0, At, B0); BAR;
      LDB(B1, 0, 1); BAR; WAIT_L(0); MMA(0, 1, At, B1); BAR;
      LDA(At, 0, 1); WAIT_V(4); BAR; WAIT_L(0); MMA(1, 0, At, B0); MMA(1, 1, At, B1); BAR; }
    { LDB(B0, 1, 0); LDA(At, 1, 0); WAIT_V(2); BAR; WAIT_L(0); MMA(0, 0, At, B0); BAR;
      LDB(B1, 1, 1); WAIT_V(0); BAR; WAIT_L(0); MMA(0, 1, At, B1); BAR;
      LDA(At, 1, 1); BAR; WAIT_L(0); MMA(1, 0, At, B0); MMA(1, 1, At, B1); BAR; }
    if (wr == 0) BAR;
    }
    if (epi == EPI_STORE) gemm_epilogue<EPI_STORE>(acc, ea, brow, bcol, quad);
    else if (epi == EPI_ROPE) gemm_epilogue<EPI_ROPE>(acc, ea, brow, bcol, quad);
    else if (epi == EPI_SWIGLU) gemm_epilogue<EPI_SWIGLU>(acc, ea, brow, bcol, quad);
    else gemm_epilogue<EPI_GELU>(acc, ea, brow, bcol, quad);
  }
#undef SA
#undef SB
#undef STAGE
#undef LDA
#undef LDB
#undef MMA
}

constexpr int KVBLK = 64;
constexpr size_t SHM_V = KVBLK * 128 * 2, SHM_K = KVBLK * 64 * 2;
constexpr float ATT_SCALE = 0.125f, ATT_THR = 8.f;
constexpr float THR2 = ATT_THR * 1.4426950408889634f;
#ifndef ATT_SUM_BIG
#define ATT_SUM_BIG 65536.f
#endif
constexpr float SUM_BIG = ATT_SUM_BIG;
#define KSWZ(row, colB) ((row) * 128 + ((colB) ^ ((((row) >> 1) & 7) << 4)))
#define SBAR() __builtin_amdgcn_sched_barrier(0)
DI int crow(int r, int hi) { return (r & 3) + 8 * (r >> 2) + 4 * hi; }

DI void qkt(f32x16& p0, f32x16& p1, const char* Ks, const char* qls, const f32x16& negm, int r32, int hi) {
  bf16x8 qr[4];
#pragma unroll
  for (int d0 = 0; d0 < 4; ++d0) qr[d0] = *reinterpret_cast<const bf16x8*>(qls + d0 * 1024);
#pragma unroll
  for (int d0 = 0; d0 < 4; ++d0) { const int cb = (d0 * 16 + hi * 8) * 2;
    const bf16x8 b0 = *reinterpret_cast<const bf16x8*>(Ks + KSWZ(r32, cb));
    const bf16x8 b1 = *reinterpret_cast<const bf16x8*>(Ks + KSWZ(32 + r32, cb));
    if (d0 == 0) { p0 = __builtin_amdgcn_mfma_f32_32x32x16_bf16(b0, qr[0], negm, 0, 0, 0); p1 = __builtin_amdgcn_mfma_f32_32x32x16_bf16(b1, qr[0], negm, 0, 0, 0); }
    else { p0 = __builtin_amdgcn_mfma_f32_32x32x16_bf16(b0, qr[d0], p0, 0, 0, 0); p1 = __builtin_amdgcn_mfma_f32_32x32x16_bf16(b1, qr[d0], p1, 0, 0, 0); } }
}
template <bool FIRST>
DI void partialSM(f32x16& p0, f32x16& p1, float& m_reg, f32x16& negm, float& alpha, const char* Ks, const char* qls, int r32, int hi) {
  float pmax = p0[0];
#pragma unroll
  for (int r = 1; r < 16; ++r) pmax = fmaxf(pmax, p0[r]);
#pragma unroll
  for (int r = 0; r < 16; ++r) pmax = fmaxf(pmax, p1[r]);
  { auto rr = __builtin_amdgcn_permlane32_swap(__float_as_uint(pmax), __float_as_uint(pmax), false, false);
    pmax = fmaxf(__uint_as_float(rr[0]), __uint_as_float(rr[1])); }
  if (FIRST) {
    alpha = 1.f; m_reg += pmax;
    const float nm = -m_reg;
#pragma unroll
    for (int r = 0; r < 16; ++r) { p0[r] -= pmax; p1[r] -= pmax; negm[r] = nm; }
#pragma unroll
    for (int r = 0; r < 16; ++r) p0[r] = __builtin_amdgcn_exp2f(p0[r]);
  } else {
#pragma unroll
    for (int r = 0; r < 16; ++r) p0[r] = __builtin_amdgcn_exp2f(p0[r]);
    asm volatile("" :: "v"(p0[0]), "v"(p0[1]), "v"(p0[2]), "v"(p0[3]), "v"(p0[4]), "v"(p0[5]), "v"(p0[6]), "v"(p0[7]),
                 "v"(p0[8]), "v"(p0[9]), "v"(p0[10]), "v"(p0[11]), "v"(p0[12]), "v"(p0[13]), "v"(p0[14]), "v"(p0[15]));
    if (__builtin_expect(__all(pmax <= THR2), 1)) { alpha = 1.f; }
    else {
      const float d = fmaxf(pmax, 0.f);
      alpha = __builtin_amdgcn_exp2f(-d);
      m_reg += d;
      const float nm = -m_reg;
#pragma unroll
      for (int r = 0; r < 16; ++r) negm[r] = nm;
      qkt(p0, p1, Ks, qls, negm, r32, hi);
#pragma unroll
      for (int r = 0; r < 16; ++r) p0[r] = __builtin_amdgcn_exp2f(p0[r]);
    }
  }
}
DI void finishSM(f32x16& p0, f32x16& p1, float alpha, float& l_reg, bf16x8& pa0, bf16x8& pa1, bf16x8& pa2, bf16x8& pa3) {
#pragma unroll
  for (int r = 0; r < 16; ++r) p1[r] = __builtin_amdgcn_exp2f(p1[r]);
  float ps = 0;
#pragma unroll
  for (int r = 0; r < 16; ++r) ps += p0[r];
#pragma unroll
  for (int r = 0; r < 16; ++r) ps += p1[r];
  { auto rr = __builtin_amdgcn_permlane32_swap(__float_as_uint(ps), __float_as_uint(ps), false, false);
    ps = __uint_as_float(rr[0]) + __uint_as_float(rr[1]); }
  l_reg = l_reg * alpha + ps;
#define PK4(P, BASE, OUT) do { u32x4 w = {cvtpk(P[BASE + 0], P[BASE + 1]), cvtpk(P[BASE + 2], P[BASE + 3]), cvtpk(P[BASE + 4], P[BASE + 5]), cvtpk(P[BASE + 6], P[BASE + 7])}; \
    OUT = *reinterpret_cast<bf16x8*>(&w); } while (0)
  PK4(p0, 0, pa0); PK4(p0, 8, pa1); PK4(p1, 0, pa2); PK4(p1, 8, pa3);
#undef PK4
}
DI int v_st(int k, int c) { const int kk = k; return ((kk >> 3) * 4 + (c >> 5)) * 512 + ((kk & 7) * 32 + (c & 31)) * 2; }
DI int v_rd_base(int lane) { return ((lane & 3) << 3) | (((lane >> 2) & 3) << 6) | (((lane >> 4) & 1) << 5) | (((lane >> 5) & 1) << 8); }
constexpr int v_rd_off(int d0, int ks, int half) { return d0 * 512 + ks * 4096 + half * 2048; }
template <int OFF> DI s16x4 tr_read(int vb) {
  s16x4 r; asm volatile("ds_read_b64_tr_b16 %0, %1 offset:%2" : "=&v"(r) : "v"(vb), "i"(OFF) : "memory"); return r;
}
#define PV_READ(S, KS) s16x4 l##S##0 = tr_read<v_rd_off(0, KS, 0)>(vb), h##S##0 = tr_read<v_rd_off(0, KS, 1)>(vb), l##S##1 = tr_read<v_rd_off(1, KS, 0)>(vb), h##S##1 = tr_read<v_rd_off(1, KS, 1)>(vb), \
    l##S##2 = tr_read<v_rd_off(2, KS, 0)>(vb), h##S##2 = tr_read<v_rd_off(2, KS, 1)>(vb), l##S##3 = tr_read<v_rd_off(3, KS, 0)>(vb), h##S##3 = tr_read<v_rd_off(3, KS, 1)>(vb)
#define PV_WAIT(S, N) asm volatile("s_waitcnt lgkmcnt(" #N ")" : "+v"(l##S##0), "+v"(h##S##0), "+v"(l##S##1), "+v"(h##S##1), "+v"(l##S##2), "+v"(h##S##2), "+v"(l##S##3), "+v"(h##S##3) :: "memory")
#define PK(L, H) (bf16x8){L[0], L[1], L[2], L[3], H[0], H[1], H[2], H[3]}
#define PV_MMA(S, PA) do { o[0] = __builtin_amdgcn_mfma_f32_32x32x16_bf16(PA, PK(l##S##0, h##S##0), o[0], 0, 0, 0); o[1] = __builtin_amdgcn_mfma_f32_32x32x16_bf16(PA, PK(l##S##1, h##S##1), o[1], 0, 0, 0); \
    o[2] = __builtin_amdgcn_mfma_f32_32x32x16_bf16(PA, PK(l##S##2, h##S##2), o[2], 0, 0, 0); o[3] = __builtin_amdgcn_mfma_f32_32x32x16_bf16(PA, PK(l##S##3, h##S##3), o[3], 0, 0, 0); } while (0)
DI void pv_d0(f32x16* o, int vb, bf16x8 pa0, bf16x8 pa1, bf16x8 pa2, bf16x8 pa3) {
  PV_READ(A, 0); PV_READ(B, 1);
  PV_WAIT(A, 8);
  PV_MMA(A, pa0);
  PV_READ(C, 2);
  PV_WAIT(B, 8);
  PV_MMA(B, pa1);
  PV_READ(D, 3);
  PV_WAIT(C, 8);
  PV_MMA(C, pa2);
  PV_WAIT(D, 0);
  PV_MMA(D, pa3);
}
#undef PV_READ
#undef PV_WAIT
#undef PV_MMA
#undef PK

DI void pack_p(const f32x16& p0, const f32x16& p1, bf16x8& pa0, bf16x8& pa1, bf16x8& pa2, bf16x8& pa3) {
#define PK4(P, BASE, OUT) do { u32x4 w = {cvtpk(P[BASE + 0], P[BASE + 1]), cvtpk(P[BASE + 2], P[BASE + 3]), cvtpk(P[BASE + 4], P[BASE + 5]), cvtpk(P[BASE + 6], P[BASE + 7])}; \
    OUT = *reinterpret_cast<bf16x8*>(&w); } while (0)
  PK4(p0, 0, pa0); PK4(p0, 8, pa1); PK4(p1, 0, pa2); PK4(p1, 8, pa3);
#undef PK4
}
DI void attn_item(const bf16* __restrict__ Qb, const bf16* __restrict__ Kcol, const bf16* __restrict__ Vcol, int kctx, int klat,
                  bf16* __restrict__ Ob, int nkeys, char* lds) {
  const int tid = (int)otid(), wid = tid >> 6, lane = tid & 63, r32 = lane & 31, hi = lane >> 5;
  char* V_lds = lds; char* K_lds = lds + 2 * SHM_V;
  float* ws = (float*)(lds + 2 * SHM_V + 2 * SHM_K) + wid * 64; float* li_l = ws; float* al_l = ws + 32;
  float m_reg = 0.f, l_reg = 0; f32x16 o[4] = {}; f32x16 negm = {};
  char* qr = lds + 2 * SHM_V + 2 * SHM_K + 2048 + wid * 4096 + lane * 16;
  const bf16* Qw = Qb + (size_t)(wid * 32 + r32) * QKVW + hi * 8;
#pragma unroll
  for (int d0 = 0; d0 < 4; ++d0) *reinterpret_cast<bf16x8*>(qr + d0 * 1024) = *reinterpret_cast<const bf16x8*>(Qw + d0 * 16);
  const int sr = tid >> 4, sc = (tid & 15) * 8, vst0 = v_st(sr, sc), vst1 = v_st(32 + sr, sc);
  const int kr = tid >> 3, kc = (tid & 7) * 8, kst = KSWZ(kr, kc * 2);
  const unsigned voV = (unsigned)(sr * QKVW + sc) * 2u, voK = (unsigned)(kr * QKVW + kc) * 2u;
  const int vb0 = (int)(uintptr_t)V_lds + v_rd_base(lane);
  bf16x8 vsA0, vsA1, ksA, vsB0, vsB1, ksB;
#define KROW(k0) ((k0) < CTXL ? kctx + (k0) : klat + (k0) - CTXL)
#define SLOAD(S, k0) do { const size_t _kr = (size_t)__builtin_amdgcn_readfirstlane(KROW(k0)); \
    const char* vb_ = (const char*)(Vcol + _kr * QKVW); const char* kb_ = (const char*)(Kcol + _kr * QKVW);     \
    vs##S##0 = *reinterpret_cast<const bf16x8*>(vb_ + voV); vs##S##1 = *reinterpret_cast<const bf16x8*>(vb_ + (size_t)32 * QKVW * 2 + voV); \
    ks##S = *reinterpret_cast<const bf16x8*>(kb_ + voK); } while (0)
#define SWRITE(b, S) do { *(bf16x8*)(V_lds + (b) * SHM_V + vst0) = vs##S##0; *(bf16x8*)(V_lds + (b) * SHM_V + vst1) = vs##S##1; \
    *(bf16x8*)(K_lds + (b) * SHM_K + kst) = ks##S; } while (0)
#define SWAIT() asm volatile("s_waitcnt vmcnt(3)" ::: "memory")
#define RESC(a) do { if (__any((a) < 1.f)) { if (hi == 0) al_l[r32] = (a); asm volatile("s_waitcnt lgkmcnt(0)" ::: "memory"); \
    _Pragma("unroll") for (int d = 0; d < 4; ++d) _Pragma("unroll") for (int r = 0; r < 16; ++r) o[d][r] *= al_l[crow(r, hi)]; } } while (0)
  f32x16 pA0, pA1, pB0, pB1; float alA, alB; bf16x8 pa0, pa1, pa2, pa3; const int NT = nkeys / KVBLK;
  SLOAD(A, 0); asm volatile("s_waitcnt vmcnt(0)" ::: "memory"); SWRITE(0, A); __syncthreads();
  qkt(pA0, pA1, K_lds, qr, negm, r32, hi); partialSM<true>(pA0, pA1, m_reg, negm, alA, K_lds, qr, r32, hi);
  SLOAD(B, KVBLK); if (2 < NT) SLOAD(A, 2 * KVBLK);
  SWAIT(); SWRITE(1, B); __syncthreads();
  for (int j = 1; j + 1 < NT; j += 2) {
    SBAR(); qkt(pB0, pB1, K_lds + SHM_K, qr, negm, r32, hi);
    finishSM(pA0, pA1, alA, l_reg, pa0, pa1, pa2, pa3); SBAR();
    SLOAD(B, (j + 2) * KVBLK); SBAR();
    pv_d0(o, vb0, pa0, pa1, pa2, pa3); partialSM<false>(pB0, pB1, m_reg, negm, alB, K_lds + SHM_K, qr, r32, hi);
    __syncthreads(); SWAIT(); SWRITE(0, A);
    RESC(alB); __syncthreads();
    SBAR(); qkt(pA0, pA1, K_lds, qr, negm, r32, hi);
    finishSM(pB0, pB1, alB, l_reg, pa0, pa1, pa2, pa3); SBAR();
    if (j + 3 < NT) SLOAD(A, (j + 3) * KVBLK); SBAR();
    pv_d0(o, vb0 + (int)SHM_V, pa0, pa1, pa2, pa3); partialSM<false>(pA0, pA1, m_reg, negm, alA, K_lds, qr, r32, hi);
    __syncthreads(); SWAIT(); SWRITE(1, B);
    RESC(alA); __syncthreads();
  }
  SBAR(); qkt(pB0, pB1, K_lds + SHM_K, qr, negm, r32, hi);
  finishSM(pA0, pA1, alA, l_reg, pa0, pa1, pa2, pa3); SBAR();
  pv_d0(o, vb0, pa0, pa1, pa2, pa3); partialSM<false>(pB0, pB1, m_reg, negm, alB, K_lds + SHM_K, qr, r32, hi);
  __syncthreads(); RESC(alB);
  finishSM(pB0, pB1, alB, l_reg, pa0, pa1, pa2, pa3); SBAR();
  pv_d0(o, vb0 + (int)SHM_V, pa0, pa1, pa2, pa3);
  if (hi == 0) li_l[r32] = l_reg; asm volatile("s_waitcnt lgkmcnt(0)" ::: "memory");
  float rli[16];
#pragma unroll
  for (int r = 0; r < 16; ++r) rli[r] = __builtin_amdgcn_rcpf(li_l[crow(r, hi)]);
  bf16* Ow = Ob + (size_t)(wid * 32) * 2048;
#pragma unroll
  for (int r = 0; r < 16; ++r) { const int orow = crow(r, hi);
#pragma unroll
    for (int d0 = 0; d0 < 4; ++d0) Ow[(size_t)orow * 2048 + d0 * 32 + r32] = __float2bfloat16(o[d0][r] * rli[r]); }
  __syncthreads();
#undef SLOAD
#undef SWRITE
#undef SWAIT
#undef RESC
#undef KROW
}

DI bool attn_item_fast(const bf16* __restrict__ Qb, const bf16* __restrict__ Kcol, const bf16* __restrict__ Vcol, int kctx, int klat,
                  bf16* __restrict__ Ob, int nkeys, char* lds) {
  const int tid = (int)otid(), wid = tid >> 6, lane = tid & 63, r32 = lane & 31, hi = lane >> 5;
  char* V_lds = lds; char* K_lds = lds + 2 * SHM_V;
  float* ws = (float*)(lds + 2 * SHM_V + 2 * SHM_K) + wid * 64; float* li_l = ws; float* al_l = ws + 32;
  float m_reg = 0.f, l_reg = 0; f32x16 o[4] = {}; f32x16 negm = {};
  char* qr = lds + 2 * SHM_V + 2 * SHM_K + 2048 + wid * 4096 + lane * 16;
  const bf16* Qw = Qb + (size_t)(wid * 32 + r32) * QKVW + hi * 8;
#pragma unroll
  for (int d0 = 0; d0 < 4; ++d0) *reinterpret_cast<bf16x8*>(qr + d0 * 1024) = *reinterpret_cast<const bf16x8*>(Qw + d0 * 16);
  const int sr = tid >> 4, sc = (tid & 15) * 8, vst0 = v_st(sr, sc), vst1 = v_st(32 + sr, sc);
  const int kr = tid >> 3, kc = (tid & 7) * 8, kst = KSWZ(kr, kc * 2);
  const unsigned voV = (unsigned)(sr * QKVW + sc) * 2u, voK = (unsigned)(kr * QKVW + kc) * 2u;
  const int vb0 = (int)(uintptr_t)V_lds + v_rd_base(lane);
  bf16x8 vsA0, vsA1, ksA, vsB0, vsB1, ksB;
#define KROW(k0) ((k0) < CTXL ? kctx + (k0) : klat + (k0) - CTXL)
#define SLOAD(S, k0) do { const size_t _kr = (size_t)__builtin_amdgcn_readfirstlane(KROW(k0)); \
    const char* vb_ = (const char*)(Vcol + _kr * QKVW); const char* kb_ = (const char*)(Kcol + _kr * QKVW);     \
    vs##S##0 = *reinterpret_cast<const bf16x8*>(vb_ + voV); vs##S##1 = *reinterpret_cast<const bf16x8*>(vb_ + (size_t)32 * QKVW * 2 + voV); \
    ks##S = *reinterpret_cast<const bf16x8*>(kb_ + voK); } while (0)
#define SWRITE(b, S) do { *(bf16x8*)(V_lds + (b) * SHM_V + vst0) = vs##S##0; *(bf16x8*)(V_lds + (b) * SHM_V + vst1) = vs##S##1; \
    *(bf16x8*)(K_lds + (b) * SHM_K + kst) = ks##S; } while (0)
#define SWAIT() asm volatile("s_waitcnt vmcnt(3)" ::: "memory")
#define RESC(a) do { if (__any((a) < 1.f)) { if (hi == 0) al_l[r32] = (a); asm volatile("s_waitcnt lgkmcnt(0)" ::: "memory"); \
    _Pragma("unroll") for (int d = 0; d < 4; ++d) _Pragma("unroll") for (int r = 0; r < 16; ++r) o[d][r] *= al_l[crow(r, hi)]; } } while (0)
  f32x16 pA0, pA1, pB0, pB1; bf16x8 pa0, pa1, pa2, pa3; const int NT = nkeys / KVBLK; float alA; bool bad_ = false;
  char* const K0 = K_lds; char* const K1 = K_lds + SHM_K;
  float hs = 0.f;
  bf16x8 na0, na1;
#define PKH(P, BASE, OUT) do { u32x4 w_ = {cvtpk(P[BASE + 0], P[BASE + 1]), cvtpk(P[BASE + 2], P[BASE + 3]), cvtpk(P[BASE + 4], P[BASE + 5]), cvtpk(P[BASE + 6], P[BASE + 7])}; \
    OUT = *reinterpret_cast<bf16x8*>(&w_); } while (0)
#define SCALE_PK(X, AL) do { u32x4 w_ = *reinterpret_cast<u32x4*>(&X); _Pragma("unroll") for (int q_ = 0; q_ < 4; ++q_) w_[q_] = cvtpk(bf_lo(w_[q_]) * (AL), bf_hi(w_[q_]) * (AL)); \
    X = *reinterpret_cast<bf16x8*>(&w_); } while (0)
#define EXP_FIRST(P0) do { _Pragma("unroll") for (int r = 0; r < 16; ++r) P0[r] = __builtin_amdgcn_exp2f(P0[r]); hs = 0.f; _Pragma("unroll") for (int r = 0; r < 16; ++r) hs += P0[r]; \
    PKH(P0, 0, na0); PKH(P0, 8, na1); } while (0)
#define ROWSUM(P1, PS) do { PS = hs; _Pragma("unroll") for (int r = 0; r < 16; ++r) PS += P1[r]; \
    auto rr_ = __builtin_amdgcn_permlane32_swap(__float_as_uint(PS), __float_as_uint(PS), false, false); PS = __uint_as_float(rr_[0]) + __uint_as_float(rr_[1]); } while (0)
#define LAZY(P1, HASQ, Q0, Q1, PS) do { \
    bad_ |= !(PS < 1.2676506e30f); \
    const float d_ = (PS > SUM_BIG) ? (__builtin_amdgcn_logf(PS) - 4.f) : 0.f; \
    const float al_ = __builtin_amdgcn_exp2f(-d_); m_reg += d_; const float nm_ = -m_reg; \
    SCALE_PK(na0, al_); SCALE_PK(na1, al_); \
    _Pragma("unroll") for (int r = 0; r < 16; ++r) { negm[r] = nm_; P1[r] *= al_; if (HASQ) { Q0[r] -= d_; Q1[r] -= d_; } } \
    l_reg = (l_reg + PS) * al_; PS = 0.f; \
    if (hi == 0) al_l[r32] = al_; asm volatile("s_waitcnt lgkmcnt(0)" ::: "memory"); \
    _Pragma("unroll") for (int d4 = 0; d4 < 4; ++d4) _Pragma("unroll") for (int r = 0; r < 16; ++r) o[d4][r] *= al_l[crow(r, hi)]; } while (0)
#define FINISH(P1, HASQ, Q0, Q1) do { float ps_; \
    _Pragma("unroll") for (int r = 0; r < 16; ++r) P1[r] = __builtin_amdgcn_exp2f(P1[r]); \
    ROWSUM(P1, ps_); \
    if (__builtin_expect(!__all(ps_ <= SUM_BIG), 0)) LAZY(P1, HASQ, Q0, Q1, ps_); \
    l_reg += ps_; pa0 = na0; pa1 = na1; PKH(P1, 0, pa2); PKH(P1, 8, pa3); } while (0)
  SLOAD(A, 0); asm volatile("s_waitcnt vmcnt(0)" ::: "memory"); SWRITE(0, A); __syncthreads();
  qkt(pA0, pA1, K0, qr, negm, r32, hi); partialSM<true>(pA0, pA1, m_reg, negm, alA, K0, qr, r32, hi);
  { hs = 0.f; _Pragma("unroll") for (int r = 0; r < 16; ++r) hs += pA0[r]; PKH(pA0, 0, na0); PKH(pA0, 8, na1); }
  SLOAD(B, KVBLK); if (2 < NT) SLOAD(A, 2 * KVBLK);
  SWAIT(); SWRITE(1, B); __syncthreads();
  for (int j = 1; j + 1 < NT; j += 2) {
    SBAR(); qkt(pB0, pB1, K1, qr, negm, r32, hi);
    FINISH(pA1, true, pB0, pB1); SBAR();
    SLOAD(B, (j + 2) * KVBLK); SBAR();
    pv_d0(o, vb0, pa0, pa1, pa2, pa3); EXP_FIRST(pB0);
    __syncthreads(); SWAIT(); SWRITE(0, A); __syncthreads();
    SBAR(); qkt(pA0, pA1, K0, qr, negm, r32, hi);
    FINISH(pB1, true, pA0, pA1); SBAR();
    if (j + 3 < NT) SLOAD(A, (j + 3) * KVBLK); SBAR();
    pv_d0(o, vb0 + (int)SHM_V, pa0, pa1, pa2, pa3); EXP_FIRST(pA0);
    __syncthreads(); SWAIT(); SWRITE(1, B); __syncthreads();
  }
  SBAR(); qkt(pB0, pB1, K1, qr, negm, r32, hi);
  FINISH(pA1, true, pB0, pB1); SBAR();
  pv_d0(o, vb0, pa0, pa1, pa2, pa3); EXP_FIRST(pB0);
  FINISH(pB1, false, pB0, pB1); SBAR();
  pv_d0(o, vb0 + (int)SHM_V, pa0, pa1, pa2, pa3);
#undef PKH
#undef SCALE_PK
  bad_ = bad_ || !(l_reg < 1.2676506e30f) || !(l_reg > 0.f);
#undef EXP_FIRST
#undef ROWSUM
#undef LAZY
#undef FINISH
  if (hi == 0) li_l[r32] = l_reg; asm volatile("s_waitcnt lgkmcnt(0)" ::: "memory");
  float rli[16];
#pragma unroll
  for (int r = 0; r < 16; ++r) rli[r] = __builtin_amdgcn_rcpf(li_l[crow(r, hi)]);
  bf16* Ow = Ob + (size_t)(wid * 32) * 2048;
#pragma unroll
  for (int r = 0; r < 16; ++r) { const int orow = crow(r, hi);
#pragma unroll
    for (int d0 = 0; d0 < 4; ++d0) Ow[(size_t)orow * 2048 + d0 * 32 + r32] = __float2bfloat16(o[d0][r] * rli[r]); }
  return __syncthreads_or(bad_ ? 1 : 0) != 0;
#undef SLOAD
#undef SWRITE
#undef SWAIT
#undef RESC
#undef KROW
}

DI void phase_attention(const Params& p, bool with_ctx, char* lds) {
  const bf16* qkv = (const bf16*)(p.ws + OFF_A);
  bf16* O16 = (bf16*)(p.ws + OFF_B);
  const int nitems = 2048 + (with_ctx ? 32 : 0);
  for (int it = blockIdx.x; it < nitems; it += gridDim.x) {
    int b, qh, qrow0, klat, nkeys;
    if (it < 2048) {
      int combo, qblk;
      if (gridDim.x == 256) { const int r = it >> 8, bid = it & 255, xcd = bid & 7, slot = bid >> 3; combo = xcd * 4 + (r >> 1); qblk = (r & 1) * 32 + slot; }
      else { combo = it >> 6; qblk = it & 63; }
      b = combo >> 4; qh = combo & 15; qrow0 = b * SEQ + qblk * 256; klat = b * SEQ; nkeys = SEQ + CTXL;
    } else {
      const int c = it - 2048; b = c >> 4; qh = c & 15; qrow0 = NLAT + b * CTXL; klat = 0; nkeys = CTXL;
    }
    const bf16* Qb = qkv + (size_t)qrow0 * QKVW + qh * 64; const bf16* Kc = qkv + 1024 + qh * 64; const bf16* Vc = qkv + 2048 + (qh >> 1) * 128;
    bf16* Ob = O16 + (size_t)qrow0 * 2048 + qh * 128;
#ifdef ATT_FORCE_SAFE
    const bool bad = attn_item_fast(Qb, Kc, Vc, NLAT + b * CTXL, klat, Ob, nkeys, lds) || true;
#else
    const bool bad = attn_item_fast(Qb, Kc, Vc, NLAT + b * CTXL, klat, Ob, nkeys, lds);
#endif
    if (bad) attn_item(Qb, Kc, Vc, NLAT + b * CTXL, klat, Ob, nkeys, lds);
  }
}

constexpr int SPLD = 136;
#define SVROW(E) ((((E) & 7) << 4) | ((E) >> 3))
DI void phase_spatial(const Params& p, int nchunks, int j, char* ldsc) {
  const bf16* Z = (const bf16*)(p.ws + OFF_A);
  bf16* Aout = (bf16*)(p.ws + OFF_B);
  const bf16* Wsp = (const bf16*)(p.ws + OFF_WSP) + (size_t)j * 8 * 128 * 128;
  const int t = (int)otid(), wid = t >> 6, lane = t & 63, fr = lane & 15, fq = lane >> 4;
  bf16* sW = (bf16*)ldsc;
  bf16* sV = sW + 128 * SPLD;
  float* sMu = (float*)(sV + 128 * SPLD);
  float* sRs = sMu + 128;
  for (int ch = blockIdx.x; ch < nchunks; ch += gridDim.x) {
    const int r0 = ch * 128;
    for (int i = 0; i < 16; ++i) {
      const int q = wid * 16 + i;
      const bf16* vr = Z + (size_t)(r0 + q) * 2048 + 1024 + lane * 16;
      const u32x4 a = *reinterpret_cast<const u32x4*>(vr), b = *reinterpret_cast<const u32x4*>(vr + 8);
      float f[16];
#pragma unroll
      for (int k = 0; k < 4; ++k) { f[2 * k] = bf_lo(a[k]); f[2 * k + 1] = bf_hi(a[k]); f[8 + 2 * k] = bf_lo(b[k]); f[8 + 2 * k + 1] = bf_hi(b[k]); }
      float s = 0.f;
#pragma unroll
      for (int k = 0; k < 16; ++k) s += f[k];
      s = wave_sum(s);
      const float mu = s * (1.f / 1024.f);
      float vs = 0.f;
#pragma unroll
      for (int k = 0; k < 16; ++k) { const float d = f[k] - mu; vs += d * d; }
      vs = wave_sum(vs);
      if (lane == 0) { sMu[q] = mu; sRs[q] = rsqrtf(vs * (1.f / 1024.f) + EPS); }
    }
    for (int g = 0; g < 8; ++g) {
      __syncthreads();
      {
        const int pr = t >> 2, qc = (t & 3) * 32;
        const bf16* src = Wsp + (size_t)g * 16384 + pr * 128 + qc;
#pragma unroll
        for (int k = 0; k < 4; ++k) *reinterpret_cast<u32x4*>(sW + pr * SPLD + qc + k * 8) = *reinterpret_cast<const u32x4*>(src + k * 8);
      }
      {
        const int q = t & 127, eb = (t >> 7) * 32;
        const bf16* vr = Z + (size_t)(r0 + q) * 2048 + 1024 + g * 128 + eb;
        const float mu = sMu[q], rs = sRs[q];
        const float* gs = p.g_sgu + j * 1024 + g * 128 + eb;
        const float* bs = p.b_sgu + j * 1024 + g * 128 + eb;
#pragma unroll
        for (int k = 0; k < 4; ++k) {
          const u32x4 a = *reinterpret_cast<const u32x4*>(vr + k * 8);
#pragma unroll
          for (int m = 0; m < 4; ++m) {
            const int e = k * 8 + 2 * m;
            const float v0 = (bf_lo(a[m]) - mu) * rs * gs[e] + bs[e], v1 = (bf_hi(a[m]) - mu) * rs * gs[e + 1] + bs[e + 1];
            sV[SVROW(eb + e) * SPLD + q] = __float2bfloat16(v0); sV[SVROW(eb + e + 1) * SPLD + q] = __float2bfloat16(v1);
          }
        }
      }
      __syncthreads();
      f32x4 acc[8];
#pragma unroll
      for (int n = 0; n < 8; ++n) acc[n] = f32x4{0.f, 0.f, 0.f, 0.f};
#pragma unroll
      for (int kk = 0; kk < 4; ++kk) {
        const bf16x8 af = *reinterpret_cast<const bf16x8*>(sW + (wid * 16 + fr) * SPLD + kk * 32 + fq * 8);
#pragma unroll
        for (int n = 0; n < 8; ++n) {
          const bf16x8 bfr = *reinterpret_cast<const bf16x8*>(sV + (n * 16 + fr) * SPLD + kk * 32 + fq * 8);
          acc[n] = __builtin_amdgcn_mfma_f32_16x16x32_bf16(af, bfr, acc[n], 0, 0, 0);
        }
      }
#pragma unroll
      for (int jj = 0; jj < 4; ++jj) {
        const int pp = wid * 16 + fq * 4 + jj;
        const float bsp = p.b_spatial[(size_t)j * 1024 + g * 128 + pp];
        const size_t rowo = (size_t)(r0 + pp);
        const u32x4 u8 = *reinterpret_cast<const u32x4*>(Z + rowo * 2048 + g * 128 + 8 * fr);
        u32x4 w;
#pragma unroll
        for (int n2 = 0; n2 < 4; ++n2)
          w[n2] = cvtpk(bf_lo(u8[n2]) * (acc[2 * n2][jj] + bsp), bf_hi(u8[n2]) * (acc[2 * n2 + 1][jj] + bsp));
        *reinterpret_cast<u32x4*>(Aout + rowo * 1024 + g * 128 + 8 * fr) = w;
      }
    }
    __syncthreads();
  }
}


#define XB_TMO      128
#define XB_XCNT(j)  (256  + 64 * (j))
#define XB_XSUB(j)  (1280 + 64 * (j))
#define XB_XGEN(j)  (2304 + 64 * (j))
#define XB_TOP      3328
#define XB_TOPGEN   3392
#define XCD_BAR_WORDS 3456
#define XB_SPIN_CAP (1u << 18)
#define LAS __attribute__((address_space(3)))
DI unsigned xb_ld(unsigned* p)              { return __hip_atomic_load(p, __ATOMIC_RELAXED, __HIP_MEMORY_SCOPE_AGENT); }
DI unsigned xb_add(unsigned* p, unsigned v) { return __hip_atomic_fetch_add(p, v, __ATOMIC_RELAXED, __HIP_MEMORY_SCOPE_AGENT); }
DI unsigned xb_xcc_id() { return (unsigned)__builtin_amdgcn_s_getreg((3 << 11) | 20) & 0xFu; }
#define XB_SPIN(cond, bar) do { unsigned _sp = 0; while (cond) { __builtin_amdgcn_s_sleep(1); \
    if ((++_sp & 255u) == 0u) { if (xb_ld(&(bar)[XB_TMO])) break; if (_sp > XB_SPIN_CAP) { atomicAdd(&(bar)[XB_TMO], 1u); break; } } } } while (0)
struct XcdBarrier { unsigned* bar; unsigned x; volatile LAS unsigned* st; };
DI XcdBarrier xcd_barrier_post(unsigned* bar, volatile LAS unsigned* st) {
  XcdBarrier b; b.bar = bar; b.x = xb_xcc_id(); b.st = st;
  if (threadIdx.x == 0) (void)xb_add(&bar[XB_XCNT(b.x)], 1u);
  return b;
}
DI void xcd_barrier_complete(unsigned* bar, unsigned x, unsigned& nloc, unsigned& nx) {
  const unsigned G = gridDim.x * gridDim.y * gridDim.z;
  unsigned sum, cnt, mine, sp = 0u;
  for (;;) {
    sum = 0u; cnt = 0u; mine = 0u;
#pragma unroll
    for (unsigned j = 0; j < 16; ++j) { const unsigned c = xb_ld(&bar[XB_XCNT(j)]); sum += c; cnt += (c > 0u) ? 1u : 0u; mine = (j == x) ? c : mine; }
    if (sum == G) break;
    __builtin_amdgcn_s_sleep(1);
    if ((++sp & 255u) == 0u) { if (xb_ld(&bar[XB_TMO])) break; if (sp > XB_SPIN_CAP) { atomicAdd(&bar[XB_TMO], 1u); break; } }
  }
  nloc = mine > 0u ? mine : 1u; nx = cnt > 0u ? cnt : 1u;
}
DI void xcd_barrier(const XcdBarrier& b) {
  asm volatile("s_waitcnt vmcnt(0)" ::: "memory");
  __syncthreads();
  if (threadIdx.x == 0) {
    unsigned* bar = b.bar;
    __builtin_amdgcn_s_waitcnt(0);
    unsigned nloc = b.st[0], nx = b.st[1];
    if (nloc == 0u) { xcd_barrier_complete(bar, b.x, nloc, nx); b.st[0] = nloc; b.st[1] = nx; }
    const unsigned old = xb_add(&bar[XB_XSUB(b.x)], 1u);
    const unsigned gen = old / nloc;
    if (old + 1u == (gen + 1u) * nloc) {
      __builtin_amdgcn_fence(__ATOMIC_RELEASE, "agent");
      asm volatile("s_waitcnt vmcnt(0)" ::: "memory");
      const unsigned og = xb_add(&bar[XB_TOP], 1u);
      const unsigned tg = og / nx;
      if (og + 1u == (tg + 1u) * nx) xb_add(&bar[XB_TOPGEN], 1u);
      else XB_SPIN(xb_ld(&bar[XB_TOPGEN]) == tg, bar);
      __builtin_amdgcn_fence(__ATOMIC_ACQUIRE, "agent");
      xb_add(&bar[XB_XGEN(b.x)], 1u);
      asm volatile("s_waitcnt vmcnt(0)" ::: "memory");
    } else {
      XB_SPIN(xb_ld(&bar[XB_XGEN(b.x)]) == gen, bar);
      __builtin_amdgcn_fence(__ATOMIC_ACQUIRE, "agent");
      asm volatile("s_waitcnt vmcnt(0)" ::: "memory");
    }
  }
  __syncthreads();
}

constexpr int NPHASES = 32;
#ifndef PHMASK
#define PHMASK 0xff
#endif
#define EN(b) ((PHMASK >> (b)) & 1)
constexpr int SHM_BYTES = SHM_GEMM + 16;

struct PhaseDesc {
  int kind, layer, epi, Mt, N, K, ldo, nrows, nq;
  unsigned long long offA, offB, offOut;
  int r_gate, r_wh, r_lh, r_sh, r_sc, r_post;
};
constexpr PhaseDesc make_desc(int ph) {
  PhaseDesc d{};
  if (ph == 0) { d.kind = 0; return d; }
  if (ph == 1) { d.kind = 1; return d; }
  int layer = 0, s = 0;
  if (ph < 10) { layer = 0; s = ph - 2; } else if (ph < 17) { layer = 1; s = ph - 10; } else if (ph < 25) { layer = 2; s = ph - 17; } else { layer = 3; s = ph - 25; }
  const bool is_attn = (layer & 1) == 0;
  const int j = layer >> 1;
  const bool ctx_live = layer < 2;
  const int nrows = ctx_live ? NROWS : NLAT;
  const int mt = NLAT / 256; const int cq = ctx_live ? 4 : 0;
  d.layer = layer; d.nrows = nrows;
  int fs = -1;
  if (is_attn) {
    if (s == 0) { d.kind = 3; d.epi = 1; d.offA = OFF_H; d.offB = OFF_WQKV + (size_t)j * 3072 * 1024 * 2; d.Mt = NLAT / 256; d.nq = 4 * (3072 / 128); d.N = 3072; d.K = 1024; d.offOut = OFF_A; d.ldo = QKVW; }
    else if (s == 1) d.kind = 4;
    else if (s == 2) d.kind = 5;
    else if (s == 3) { d.kind = 3; d.epi = 0; d.offA = OFF_H; d.offB = OFF_WAO + (size_t)j * 1024 * 1024 * 2; d.Mt = mt; d.nq = cq * 8; d.N = 1024; d.K = 1024; d.offOut = OFF_A; d.ldo = 1024; }
    else fs = s - 4;
  } else {
    if (s == 0) { d.kind = 3; d.epi = 3; d.offA = OFF_H; d.offB = OFF_WUV + (size_t)j * 2048 * 1024 * 2; d.Mt = mt; d.nq = cq * 16; d.N = 2048; d.K = 1024; d.offOut = OFF_A; d.ldo = 2048; }
    else if (s == 1) d.kind = 6;
    else if (s == 2) { d.kind = 3; d.epi = 0; d.offA = OFF_B; d.offB = OFF_WCO + (size_t)j * 1024 * 1024 * 2; d.Mt = mt; d.nq = cq * 8; d.N = 1024; d.K = 1024; d.offOut = OFF_A; d.ldo = 1024; }
    else fs = s - 3;
  }
  if (fs == 0) { d.kind = 2; d.offA = OFF_A; d.r_gate = 2048; d.r_post = 0; d.r_wh = 1; d.r_lh = layer; d.r_sh = 3072; d.r_sc = 4096; }
  else if (fs == 1) { d.kind = 3; d.epi = 2; d.offA = OFF_H; d.offB = OFF_WFI + (size_t)layer * 5632 * 1024 * 2; d.Mt = mt; d.nq = cq * 44; d.N = 5632; d.K = 1024; d.offOut = OFF_A; d.ldo = FH; }
  else if (fs == 2) { d.kind = 3; d.epi = 0; d.offA = OFF_A; d.offB = OFF_WFO + (size_t)layer * 1024 * 2816 * 2; d.Mt = mt; d.nq = cq * 8; d.N = 1024; d.K = 2816; d.offOut = OFF_B; d.ldo = 1024; }
  else if (fs == 3) { d.kind = 2; d.offA = OFF_B; d.r_gate = 5120; d.r_post = 1; d.r_wh = layer < 3 ? 1 : 0; d.r_lh = layer < 3 ? layer + 1 : 0; d.r_sh = 0; d.r_sc = 1024; }
  return d;
}
struct PhaseTable { PhaseDesc d[NPHASES]; };
constexpr PhaseTable make_table() { PhaseTable t{}; for (int i = 0; i < NPHASES; ++i) t.d[i] = make_desc(i); return t; }
__constant__ PhaseTable g_phases = make_table();

DI void run_phase(const Params& p, int ph, char* lds) {
  const PhaseDesc& d = g_phases.d[ph];
  const int kind = d.kind, layer = d.layer;
  switch (kind) {
    case 2: if (EN(2)) phase_rowwise<false>(layer == 0 && d.r_post == 0, p, d.nrows, (const bf16*)(p.ws + d.offA), layer, d.r_gate, (d.r_post ? p.g_ffn_post : p.g_mix_post) + layer * 1024, d.r_wh != 0,
                                            (d.r_post ? p.g_mix_pre : p.g_ffn_pre) + d.r_lh * 1024, d.r_lh, d.r_sh, d.r_sc); break;
    case 3: if (EN(3)) { EpiArgs ea{(bf16*)(p.ws + d.offOut), d.ldo, p.b_uv + (layer >> 1) * 2048, (const float2*)(p.ws + OFF_ROPE)};
              gemm_phase(d.epi, (const bf16*)(p.ws + d.offA), (const bf16*)(p.ws + d.offB), d.Mt, d.N, d.K, d.nq, ea, lds); } break;
    case 4: if (EN(4)) phase_attention(p, layer < 2, lds); break;
    case 5: if (EN(5)) phase_attn_finish(p, d.nrows, layer >> 1, layer == 0 ? 0.2f : 0.47071302f); break;
    case 6: if (EN(6)) phase_spatial(p, d.nrows / 128, layer >> 1, lds); break;
    default: break;
  }
}

__global__ void __launch_bounds__(NTHR, 2) mega_kernel(Params p, int ph_lo, int ph_hi) {
  extern __shared__ __attribute__((aligned(16))) char lds[];
  cg::grid_group grid = cg::this_grid();
  const bool full = (ph_lo == 0 && ph_hi == NPHASES);
  unsigned* bar = (unsigned*)(p.ws + OFF_BAR);
  volatile LAS unsigned* st = (volatile LAS unsigned*)(LAS char*)(lds + SHM_GEMM);
  if (full) {
    if (threadIdx.x < 2) st[threadIdx.x] = 0u;
    if (blockIdx.x == 0) for (int i = threadIdx.x; i < XCD_BAR_WORDS; i += NTHR) bar[i] = 0u;
    __syncthreads();
  }
  XcdBarrier xb; xb.bar = bar; xb.x = 0; xb.st = st;
  int ph = ph_lo;
  if (ph == 0 && ph < ph_hi) {
    if (EN(0)) phase_prologue(p, lds);
    ++ph;
    if (ph < ph_hi) { grid.sync(); if (full) xb = xcd_barrier_post(bar, st); }
  }
  if (ph == 1 && ph < ph_hi) {
    if (EN(1)) phase_rowwise<true>(false, p, NROWS, nullptr, 0, 0, nullptr, true, p.g_mix_pre, 0, 0, 1024);
    ++ph;
    if (ph < ph_hi) { if (full) xcd_barrier(xb); else grid.sync(); }
  }
  for (; ph < ph_hi; ++ph) {
    run_phase(p, ph, lds);
    if (ph + 1 < ph_hi) { if (full) xcd_barrier(xb); else grid.sync(); }
  }
}

extern "C" void kernel_launch(void* const* d_in, const int* in_sizes, int n_in, void* d_out, int out_size, void* d_ws, size_t ws_size, hipStream_t stream) {
  static int grid_blocks = 0;
  if (grid_blocks == 0) {
    if (n_in != 26 || out_size != NLAT * DM || ws_size < WS_END) {
      fprintf(stderr, "kernel_launch: unexpected shapes n_in %d out %d ws %zu (need %zu)\n", n_in, out_size, ws_size, (size_t)WS_END); grid_blocks = -1; return; }
    int dev = 0, cus = 0, per_cu = 0;
    hipGetDevice(&dev);
    hipDeviceGetAttribute(&cus, hipDeviceAttributeMultiprocessorCount, dev);
    if (hipFuncSetAttribute((const void*)mega_kernel, hipFuncAttributeMaxDynamicSharedMemorySize, SHM_BYTES) != hipSuccess) {
      fprintf(stderr, "kernel_launch: hipFuncSetAttribute failed\n"); grid_blocks = -1; return; }
    hipOccupancyMaxActiveBlocksPerMultiprocessor(&per_cu, (const void*)mega_kernel, NTHR, SHM_BYTES);
    if (per_cu < 1) { fprintf(stderr, "kernel_launch: occupancy query says %d blocks/CU\n", per_cu); per_cu = 1; }
    grid_blocks = cus * per_cu;
    (void)hipGetLastError();
  }
  if (grid_blocks < 0) return;
  Params p{};
  const float** pp = (const float**)&p;
  for (int i = 0; i < 26; ++i) pp[i] = (const float*)d_in[i];
  p.out = (float*)d_out; p.ws = (char*)d_ws;
#if SINGLE_LAUNCH
  int lo = 0, hi = NPHASES;
  void* args[] = {&p, &lo, &hi};
  hipError_t e = hipLaunchCooperativeKernel((const void*)mega_kernel, dim3(grid_blocks), dim3(NTHR), args, SHM_BYTES, stream);
  if (e != hipSuccess) fprintf(stderr, "cooperative launch failed: %s (grid %d)\n", hipGetErrorString(e), grid_blocks);
#else
  for (int ph = 0; ph < NPHASES; ++ph) {
    hipLaunchKernelGGL(mega_kernel, dim3(grid_blocks), dim3(NTHR), SHM_BYTES, stream, p, ph, ph + 1);
  }
#endif
}
```

```cpp
#include <hip/hip_runtime.h>
#include <hip/hip_bf16.h>
#include <hip/hip_cooperative_groups.h>
#include <cstdio>
#include <cstdint>
namespace cg = cooperative_groups;

#ifndef SINGLE_LAUNCH
#define SINGLE_LAUNCH 1
#endif

using bf16 = __hip_bfloat16;
using bf16x8 = __attribute__((ext_vector_type(8))) short;
using s16x4  = __attribute__((ext_vector_type(4))) short;
using f32x16 = __attribute__((ext_vector_type(16))) float;
using f32x4  = __attribute__((ext_vector_type(4))) float;
using u32x4  = __attribute__((ext_vector_type(4))) unsigned;
using u32x2  = __attribute__((ext_vector_type(2))) unsigned;
#define DI __device__ __forceinline__

constexpr int DM = 1024, NBATCH = 2, SEQ = 16384, CTXL = 256;
constexpr int NLAT = NBATCH * SEQ, NCTX = NBATCH * CTXL, NROWS = NLAT + NCTX;
constexpr int FH = 2816, QKVW = 3072, NMOD = 6;
constexpr int NTHR = 512;
constexpr float EPS = 1e-6f;

constexpr size_t SZ_WQKV = 2ull * 3072 * 1024 * 2, SZ_WAO = 2ull * 1024 * 1024 * 2, SZ_WUV = 2ull * 2048 * 1024 * 2, SZ_WCO = 2ull * 1024 * 1024 * 2;
constexpr size_t SZ_WFI = 4ull * 5632 * 1024 * 2, SZ_WFO = 4ull * 1024 * 2816 * 2, SZ_WSP = 2ull * 8 * 128 * 128 * 2;
constexpr size_t SZ_MODS = 4ull * 3 * 6144 * 4, SZ_ROPE = 256ull * 16 * 2 * 4, SZ_XCTX = 512ull * 1024 * 4;
constexpr size_t SZ_H = (size_t)NROWS * 1024 * 2, SZ_A = (size_t)NROWS * 3072 * 2, SZ_B = (size_t)NROWS * 2048 * 2;
constexpr size_t OFF_WQKV = 0, OFF_WAO = OFF_WQKV + SZ_WQKV, OFF_WUV = OFF_WAO + SZ_WAO, OFF_WCO = OFF_WUV + SZ_WUV, OFF_WFI = OFF_WCO + SZ_WCO,
                 OFF_WFO = OFF_WFI + SZ_WFI, OFF_WSP = OFF_WFO + SZ_WFO, OFF_MODS = OFF_WSP + SZ_WSP, OFF_ROPE = OFF_MODS + SZ_MODS,
                 OFF_XCTX = OFF_ROPE + SZ_ROPE, OFF_H = OFF_XCTX + SZ_XCTX, OFF_A = OFF_H + SZ_H, OFF_B = OFF_A + SZ_A, OFF_BAR = OFF_B + SZ_B, WS_END = OFF_BAR + 16384;

struct Params {
  const float *x, *c, *ctx, *c_ctx, *w_ada, *b_ada, *g_mix_pre, *g_mix_post, *g_ffn_pre, *g_ffn_post,
      *w_qkv, *w_attn_out, *lam_q1, *lam_k1, *lam_q2, *lam_k2, *g_subln,
      *w_uv, *b_uv, *g_sgu, *b_sgu, *w_spatial, *b_spatial, *w_cmlp_out, *w_ffn_in, *w_ffn_out;
  float* out; char* ws;
};

DI unsigned cvtpk(float lo, float hi) { unsigned r; asm volatile("v_cvt_pk_bf16_f32 %0, %1, %2" : "=v"(r) : "v"(lo), "v"(hi)); return r; }
DI float bf_lo(unsigned u) { return __uint_as_float(u << 16); }
DI float bf_hi(unsigned u) { return __uint_as_float(u & 0xffff0000u); }
template <int M> DI float swz_xor(float v) { return __int_as_float(__builtin_amdgcn_ds_swizzle(__float_as_int(v), 0x1f | (M << 10))); }
DI float wave_sum(float v) {
  v += swz_xor<16>(v); v += swz_xor<8>(v); v += swz_xor<4>(v); v += swz_xor<2>(v); v += swz_xor<1>(v);
  auto rr = __builtin_amdgcn_permlane32_swap(__float_as_uint(v), __float_as_uint(v), false, false);
  return __uint_as_float(rr[0]) + __uint_as_float(rr[1]);
}
DI unsigned otid() { unsigned t = threadIdx.x; asm volatile("" : "+v"(t)); return t; }
using f32x2 = __attribute__((ext_vector_type(2))) float;
DI f32x2 gelu_pk(f32x2 v) {
  const f32x2 av = __builtin_elementwise_abs(v), d = av * 0.2316418882f + 1.0f;
  f32x2 t; t.x = __builtin_amdgcn_rcpf(d.x); t.y = __builtin_amdgcn_rcpf(d.y);
  f32x2 q = t * 0.5307027145f + (-0.7265760135f); q = q * t + 0.7107068705f; q = q * t + (-0.142248368f); q = q * t + 0.127414796f; q = q * t;
  const f32x2 s = (v * v) * (-0.72134752044f);
  f32x2 e; e.x = __builtin_amdgcn_exp2f(s.x); e.y = __builtin_amdgcn_exp2f(s.y);
  const f32x2 m = v * (q * e), r = v - m;
  f32x2 o; o.x = v.x < 0.f ? m.x : r.x; o.y = v.y < 0.f ? m.y : r.y; return o;
}
DI float silu_f(float v) { return v * __builtin_amdgcn_rcpf(1.f + __builtin_amdgcn_exp2f(-1.4426950408889634f * v)); }
DI float* xres(const Params& p, int row) { return row < NLAT ? p.out + (size_t)row * DM : (float*)(p.ws + OFF_XCTX) + (size_t)(row - NLAT) * DM; }
DI int modvec(int row) { return row < SEQ ? 0 : (row < NLAT ? 1 : 2); }

constexpr int NI_MODS = 4 * 96;
constexpr int T_QKV = 16 * 48, T_AO = 16 * 16, T_UV = 16 * 32, T_CO = 16 * 16, T_FI = 16 * 88, T_FO = 44 * 16;
constexpr int NI_TR = 2 * T_QKV + 2 * T_AO + 2 * T_UV + 2 * T_CO + 4 * T_FI + 4 * T_FO;
constexpr int NI_SP = 64;
constexpr int NI_P0 = NI_MODS + NI_TR + NI_SP + 1;

DI void tr_tile(const float* __restrict__ src, bf16* __restrict__ dst, int K, int N, int tk, int tn, int perm, unsigned* lds) {
  const int t = (int)otid();
  const int k0 = tk * 64, n0 = tn * 64;
  {
    const int kp = t >> 4, nn = (t & 15) * 4;
    const float4 a = *reinterpret_cast<const float4*>(src + (size_t)(k0 + 2 * kp) * N + n0 + nn);
    const float4 b = *reinterpret_cast<const float4*>(src + (size_t)(k0 + 2 * kp + 1) * N + n0 + nn);
    lds[(nn + 0) * 33 + kp] = cvtpk(a.x, b.x);
    lds[(nn + 1) * 33 + kp] = cvtpk(a.y, b.y);
    lds[(nn + 2) * 33 + kp] = cvtpk(a.z, b.z);
    lds[(nn + 3) * 33 + kp] = cvtpk(a.w, b.w);
  }
  __syncthreads();
  {
    const int n = t >> 3, k4 = (t & 7) * 4;
    u32x4 v = {lds[n * 33 + k4], lds[n * 33 + k4 + 1], lds[n * 33 + k4 + 2], lds[n * 33 + k4 + 3]};
    int c = n0 + n, drow = c;
    if (perm == 1) { const int nsel = c >= FH ? 1 : 0; const int j = c - nsel * FH; drow = (j >> 4) * 32 + nsel * 16 + (j & 15); }
    else if (perm == 2 || (perm == 3 && c >= 2048)) drow = (c & ~31) | ((c & 1) << 4) | ((c & 31) >> 1);
    *reinterpret_cast<u32x4*>(dst + (size_t)drow * K + k0 + k4 * 2) = v;
  }
  __syncthreads();
}

DI void phase_prologue(const Params& p, char* ldsc) {
  unsigned* lds = (unsigned*)ldsc;
  float* ldsf = (float*)ldsc;
  const int t = (int)otid(), wid = t >> 6, lane = t & 63;
  for (int it = blockIdx.x; it < NI_P0; it += gridDim.x) {
    if (it < NI_MODS) {
      const int layer = it / 96, cb = it % 96;
      for (int i = t; i < 3 * 1024; i += NTHR) {
        const int v = i >> 10, k = i & 1023;
        const float cv = v < 2 ? p.c[v * 1024 + k] : p.c_ctx[k];
        ldsf[i] = silu_f(cv);
      }
      __syncthreads();
      const float* w = p.w_ada + (size_t)layer * 1024 * 6144 + cb * 64 + lane;
      float a0 = 0.f, a1 = 0.f, a2 = 0.f;
      const int kb = wid * 128;
#pragma unroll 8
      for (int k = 0; k < 128; ++k) {
        const float wv = w[(size_t)(kb + k) * 6144];
        a0 = fmaf(ldsf[kb + k], wv, a0); a1 = fmaf(ldsf[1024 + kb + k], wv, a1); a2 = fmaf(ldsf[2048 + kb + k], wv, a2);
      }
      __syncthreads();
      ldsf[3072 + (wid * 3 + 0) * 64 + lane] = a0; ldsf[3072 + (wid * 3 + 1) * 64 + lane] = a1; ldsf[3072 + (wid * 3 + 2) * 64 + lane] = a2;
      __syncthreads();
      if (t < 192) {
        const int v = t >> 6, cl = t & 63;
        float s = 0.f;
#pragma unroll
        for (int w8 = 0; w8 < 8; ++w8) s += ldsf[3072 + (w8 * 3 + v) * 64 + cl];
        const int col = cb * 64 + cl;
        ((float*)(p.ws + OFF_MODS))[(size_t)(layer * 3 + v) * 6144 + col] = s + p.b_ada[layer * 6144 + col];
      }
      __syncthreads();
    } else if (it < NI_MODS + NI_TR) {
      int r = it - NI_MODS;
      const float* src; bf16* dst; int K, N, tn_cnt; int perm = 2;
      if (r < 2 * T_QKV) { const int j = r / T_QKV; r %= T_QKV; K = 1024; N = 3072; src = p.w_qkv + (size_t)j * K * N; dst = (bf16*)(p.ws + OFF_WQKV) + (size_t)j * K * N; perm = 3; }
      else if ((r -= 2 * T_QKV) < 2 * T_AO) { const int j = r / T_AO; r %= T_AO; K = 1024; N = 1024; src = p.w_attn_out + (size_t)j * K * N; dst = (bf16*)(p.ws + OFF_WAO) + (size_t)j * K * N; }
      else if ((r -= 2 * T_AO) < 2 * T_UV) { const int j = r / T_UV; r %= T_UV; K = 1024; N = 2048; src = p.w_uv + (size_t)j * K * N; dst = (bf16*)(p.ws + OFF_WUV) + (size_t)j * K * N; }
      else if ((r -= 2 * T_UV) < 2 * T_CO) { const int j = r / T_CO; r %= T_CO; K = 1024; N = 1024; src = p.w_cmlp_out + (size_t)j * K * N; dst = (bf16*)(p.ws + OFF_WCO) + (size_t)j * K * N; }
      else if ((r -= 2 * T_CO) < 4 * T_FI) { const int j = r / T_FI; r %= T_FI; K = 1024; N = 5632; src = p.w_ffn_in + (size_t)j * K * N; dst = (bf16*)(p.ws + OFF_WFI) + (size_t)j * K * N; perm = 1; }
      else { r -= 4 * T_FI; const int j = r / T_FO; r %= T_FO; K = 2816; N = 1024; src = p.w_ffn_out + (size_t)j * K * N; dst = (bf16*)(p.ws + OFF_WFO) + (size_t)j * K * N; }
      tn_cnt = N / 64;
      tr_tile(src, dst, K, N, r / tn_cnt, r % tn_cnt, perm, lds);
    } else if (it < NI_MODS + NI_TR + NI_SP) {
      const int r = it - NI_MODS - NI_TR;
      const size_t e = (size_t)r * 4096 + t * 8;
      const float4 a = *reinterpret_cast<const float4*>(p.w_spatial + e), b = *reinterpret_cast<const float4*>(p.w_spatial + e + 4);
      u32x4 v = {cvtpk(a.x, a.y), cvtpk(a.z, a.w), cvtpk(b.x, b.y), cvtpk(b.z, b.w)};
      *reinterpret_cast<u32x4*>((bf16*)(p.ws + OFF_WSP) + e) = v;
    } else {
      float2* tab = (float2*)(p.ws + OFF_ROPE);
      for (int i = t; i < 4096; i += NTHR) {
        const int pos = i >> 4, f = i & 15;
        const float inv = powf(10000.f, -(float)(2 * f) / 32.f);
        const float ang = (float)pos * inv;
        tab[i] = make_float2(cosf(ang), sinf(ang));
      }
    }
  }
}

template <bool FIRST, int R>
DI void rowwise_batch(bool src_in, const Params& p, int row0, int lane, const bf16* __restrict__ ybr, int lb, int gate_off, const float* __restrict__ g_post,
                      bool write_h, const float* __restrict__ g_pre, int lh, int sh_off, int sc_off) {
  const float* mods = (const float*)(p.ws + OFF_MODS);
  bf16* H = (bf16*)(p.ws + OFF_H);
  const int mv = modvec(row0);
  float4 xv[R][4]; u32x2 yv[R][4];
#pragma unroll
  for (int r = 0; r < R; ++r) {
    const int row = row0 + r;
    const float* xin = (FIRST || src_in) ? (row < NLAT ? p.x + (size_t)row * DM : p.ctx + (size_t)(row - NLAT) * DM) : xres(p, row);
#pragma unroll
    for (int i = 0; i < 4; ++i) { const f32x4 t_ = __builtin_nontemporal_load(reinterpret_cast<const f32x4*>(xin + lane * 4 + 256 * i)); xv[r][i] = make_float4(t_[0], t_[1], t_[2], t_[3]); }
    if (!FIRST) {
#pragma unroll
      for (int i = 0; i < 4; ++i) yv[r][i] = __builtin_nontemporal_load(reinterpret_cast<const u32x2*>(ybr + (size_t)row * DM + lane * 4 + 256 * i));
    }
  }
  if (!FIRST) {
    const float* gate = mods + (size_t)(lb * 3 + mv) * 6144 + gate_off;
    float4 gg[4];
#pragma unroll
    for (int i = 0; i < 4; ++i) {
      const int col = lane * 4 + 256 * i;
      const float4 gt = *reinterpret_cast<const float4*>(gate + col), gp = *reinterpret_cast<const float4*>(g_post + col);
      gg[i] = make_float4(gt.x * gp.x, gt.y * gp.y, gt.z * gp.z, gt.w * gp.w);
    }
#pragma unroll
    for (int r = 0; r < R; ++r) {
      float yf[4][4];
      float ss = 0.f;
#pragma unroll
      for (int i = 0; i < 4; ++i) {
        yf[i][0] = bf_lo(yv[r][i][0]); yf[i][1] = bf_hi(yv[r][i][0]); yf[i][2] = bf_lo(yv[r][i][1]); yf[i][3] = bf_hi(yv[r][i][1]);
        ss += yf[i][0] * yf[i][0] + yf[i][1] * yf[i][1] + yf[i][2] * yf[i][2] + yf[i][3] * yf[i][3];
      }
      ss = wave_sum(ss);
      const float rstd = rsqrtf(ss * (1.f / DM) + EPS);
#pragma unroll
      for (int i = 0; i < 4; ++i) {
        xv[r][i].x += gg[i].x * (yf[i][0] * rstd); xv[r][i].y += gg[i].y * (yf[i][1] * rstd);
        xv[r][i].z += gg[i].z * (yf[i][2] * rstd); xv[r][i].w += gg[i].w * (yf[i][3] * rstd);
      }
    }
  }
  if (!FIRST)
#pragma unroll
  for (int r = 0; r < R; ++r) {
    float* xr = xres(p, row0 + r);
#pragma unroll
    for (int i = 0; i < 4; ++i) { const f32x4 t_ = {xv[r][i].x, xv[r][i].y, xv[r][i].z, xv[r][i].w}; __builtin_nontemporal_store(t_, reinterpret_cast<f32x4*>(xr + lane * 4 + 256 * i)); }
  }
  if (write_h) {
    const float* sh = mods + (size_t)(lh * 3 + mv) * 6144 + sh_off;
    const float* sc = mods + (size_t)(lh * 3 + mv) * 6144 + sc_off;
    float4 ga[4], sb[4];
#pragma unroll
    for (int i = 0; i < 4; ++i) {
      const int col = lane * 4 + 256 * i;
      const float4 g = *reinterpret_cast<const float4*>(g_pre + col), s2 = *reinterpret_cast<const float4*>(sc + col);
      sb[i] = *reinterpret_cast<const float4*>(sh + col);
      ga[i] = make_float4(g.x * (1.f + s2.x), g.y * (1.f + s2.y), g.z * (1.f + s2.z), g.w * (1.f + s2.w));
    }
#pragma unroll
    for (int r = 0; r < R; ++r) {
      float ss = 0.f;
#pragma unroll
      for (int i = 0; i < 4; ++i) ss += xv[r][i].x * xv[r][i].x + xv[r][i].y * xv[r][i].y + xv[r][i].z * xv[r][i].z + xv[r][i].w * xv[r][i].w;
      ss = wave_sum(ss);
      const float rstd = rsqrtf(ss * (1.f / DM) + EPS);
#pragma unroll
      for (int i = 0; i < 4; ++i) {
        const int col = lane * 4 + 256 * i;
        const float h0 = xv[r][i].x * rstd * ga[i].x + sb[i].x, h1 = xv[r][i].y * rstd * ga[i].y + sb[i].y;
        const float h2 = xv[r][i].z * rstd * ga[i].z + sb[i].z, h3 = xv[r][i].w * rstd * ga[i].w + sb[i].w;
        u32x2 o = {cvtpk(h0, h1), cvtpk(h2, h3)};
        *reinterpret_cast<u32x2*>(H + (size_t)(row0 + r) * DM + col) = o;
      }
    }
  }
}
template <bool FIRST>
DI void phase_rowwise(bool src_in, const Params& p, int nrows, const bf16* __restrict__ ybr, int lb, int gate_off, const float* __restrict__ g_post,
                      bool write_h, const float* __restrict__ g_pre, int lh, int sh_off, int sc_off) {
  const int t_ = (int)otid(); const int wid = t_ >> 6, lane = t_ & 63;
  for (int g = blockIdx.x * 8 + wid; g < NLAT / 4; g += gridDim.x * 8)
    rowwise_batch<FIRST, 4>(src_in, p, g * 4, lane, ybr, lb, gate_off, g_post, write_h, g_pre, lh, sh_off, sc_off);
  for (int row = NLAT + blockIdx.x * 8 + wid; row < nrows; row += gridDim.x * 8)
    rowwise_batch<FIRST, 1>(src_in, p, row, lane, ybr, lb, gate_off, g_post, write_h, g_pre, lh, sh_off, sc_off);
}

DI void phase_attn_finish(const Params& p, int nrows, int j, float lam_init) {
  const int t_ = (int)otid(); const int wid = t_ >> 6, lane = t_ & 63;
  float d1 = p.lam_q1[j * 64 + lane] * p.lam_k1[j * 64 + lane], d2 = p.lam_q2[j * 64 + lane] * p.lam_k2[j * 64 + lane];
  d1 = wave_sum(d1); d2 = wave_sum(d2);
  const float lam = __expf(d1) - __expf(d2) + lam_init;
  const bf16* O16 = (const bf16*)(p.ws + OFF_B);
  bf16* Aout = (bf16*)(p.ws + OFF_H);
  const int h = lane >> 3, e0 = (lane & 7) * 16;
  float gs[16];
#pragma unroll
  for (int i = 0; i < 16; ++i) gs[i] = p.g_subln[j * 128 + e0 + i] * (1.f - lam_init);
  for (int row = blockIdx.x * 8 + wid; row < nrows; row += gridDim.x * 8) {
    const bf16* o0 = O16 + (size_t)row * 2048 + (2 * h) * 128 + e0;
    const u32x4 a0 = *reinterpret_cast<const u32x4*>(o0), a1 = *reinterpret_cast<const u32x4*>(o0 + 8);
    const u32x4 b0 = *reinterpret_cast<const u32x4*>(o0 + 128), b1 = *reinterpret_cast<const u32x4*>(o0 + 136);
    float v[16];
#pragma unroll
    for (int i = 0; i < 4; ++i) {
      v[2 * i] = bf_lo(a0[i]) - lam * bf_lo(b0[i]); v[2 * i + 1] = bf_hi(a0[i]) - lam * bf_hi(b0[i]);
      v[8 + 2 * i] = bf_lo(a1[i]) - lam * bf_lo(b1[i]); v[8 + 2 * i + 1] = bf_hi(a1[i]) - lam * bf_hi(b1[i]);
    }
    float ss = 0.f;
#pragma unroll
    for (int i = 0; i < 16; ++i) ss += v[i] * v[i];
    ss += swz_xor<1>(ss); ss += swz_xor<2>(ss); ss += swz_xor<4>(ss);
    const float rstd = rsqrtf(ss * (1.f / 128.f) + EPS);
    u32x4 w0, w1;
#pragma unroll
    for (int i = 0; i < 4; ++i) {
      w0[i] = cvtpk(v[2 * i] * rstd * gs[2 * i], v[2 * i + 1] * rstd * gs[2 * i + 1]);
      w1[i] = cvtpk(v[8 + 2 * i] * rstd * gs[8 + 2 * i], v[8 + 2 * i + 1] * rstd * gs[8 + 2 * i + 1]);
    }
    bf16* dst = Aout + (size_t)row * DM + h * 128 + e0;
    *reinterpret_cast<u32x4*>(dst) = w0; *reinterpret_cast<u32x4*>(dst + 8) = w1;
  }
}

constexpr int BM = 256, BK = 64, HALF = 128, HT = HALF * BK, SHM_GEMM = 8 * HT * 2;
DI int lds_byte(int r, int c) { int st = (r >> 4) * 2 + (c >> 5), rr = r & 15, cc = c & 31, ob = rr * 64 + cc * 2; return st * 1024 + (ob ^ (((ob >> 9) & 1) << 5)); }
DI void stage_rc(int b, int& R, int& C) { int st = b / 1024, sb = b % 1024, swz = sb ^ (((sb >> 9) & 1) << 5); R = (st >> 1) * 16 + swz / 64; C = (st & 1) * 32 + (swz % 64) / 2; }

struct EpiArgs { bf16* out; int ldo; const float* aux; const float2* rope; };

constexpr int EPI_STORE = 0, EPI_ROPE = 1, EPI_SWIGLU = 2, EPI_GELU = 3;
constexpr float QSCALE = 0.125f * 1.4426950408889634f;

template <int EPI>
DI void gemm_epilogue(f32x4 (&acc)[2][2][4][2], const EpiArgs& ea, int brow, int bcol, bool quad) {
  const unsigned tid = otid();
  const int wid = tid >> 6, lane = tid & 63, wr = wid >> 2, wc = wid & 3, fr = lane & 15, fq = lane >> 4;
  const int ldo = ea.ldo;
  const int ocol0 = (EPI == EPI_SWIGLU) ? (bcol >> 1) : bcol;
  bf16* obase = ea.out + (size_t)brow * ldo + ocol0;
  const unsigned tro = (unsigned)((wr * 64 + fq * 4) * ldo + ((EPI == EPI_SWIGLU) ? wc * 16 + fr : wc * 32 + 2 * fr));
  float bia[2][2];
  if constexpr (EPI == EPI_GELU) {
#pragma unroll
    for (int bj = 0; bj < 2; ++bj)
#pragma unroll
      for (int n = 0; n < 2; ++n) bia[bj][n] = ea.aux[bcol + bj * HALF + wc * 32 + 2 * fr + n];
  }
  const bool do_rope = (EPI == EPI_ROPE) && bcol < 2048 && brow < NLAT;
  const int axis = wc & 1;
  float2 csr[2] = {make_float2(1.f, 0.f), make_float2(1.f, 0.f)};
  float2 csc[4][4];
  if constexpr (EPI == EPI_ROPE) {
#pragma unroll
    for (int m = 0; m < 4; ++m)
#pragma unroll
      for (int j = 0; j < 4; ++j) csc[m][j] = make_float2(1.f, 0.f);
    if (do_rope) {
      if (axis) {
#pragma unroll
        for (int m = 0; m < 4; ++m)
#pragma unroll
          for (int j = 0; j < 4; ++j) csc[m][j] = ea.rope[((m * 16 + fq * 4 + j) & 63) * 16 + fr];
      } else {
#pragma unroll
        for (int ai = 0; ai < 2; ++ai) csr[ai] = ea.rope[(((brow & (SEQ - 1)) >> 6) + ai * 2 + wr) * 16 + fr];
      }
    }
  }
#pragma unroll
  for (int ai = 0; ai < 2; ++ai)
#pragma unroll
    for (int m = 0; m < 4; ++m)
#pragma unroll
      for (int j = 0; j < 4; ++j) {
        if (quad && ai) continue;
        bf16* rp = obase + (size_t)(ai * HALF + m * 16 + j) * ldo;
        float2 cs = make_float2(1.f, 0.f);
        if constexpr (EPI == EPI_ROPE) cs = axis ? csc[m][j] : csr[ai];
#pragma unroll
        for (int bj = 0; bj < 2; ++bj) {
          if (quad && bj) continue;
          float v0 = acc[ai][bj][m][0][j], v1 = acc[ai][bj][m][1][j];
          if constexpr (EPI == EPI_STORE) {
            *reinterpret_cast<unsigned*>(rp + tro + bj * HALF) = cvtpk(v0, v1);
          } else if constexpr (EPI == EPI_ROPE) {
            const float o0 = v0 * cs.x - v1 * cs.y, o1 = v1 * cs.x + v0 * cs.y;
            const float qs = (bcol < 1024) ? QSCALE : 1.f;
            *reinterpret_cast<unsigned*>(rp + tro + bj * HALF) = cvtpk(o0 * qs, o1 * qs);
          } else if constexpr (EPI == EPI_SWIGLU) {
            rp[tro + bj * (HALF / 2)] = __float2bfloat16(silu_f(v0) * v1);
          } else {
            v0 += bia[bj][0]; v1 += bia[bj][1];
            { const f32x2 g_ = gelu_pk((f32x2){v0, v1}); v0 = g_.x; v1 = g_.y; }
            *reinterpret_cast<unsigned*>(rp + tro + bj * HALF) = cvtpk(v0, v1);
          }
        }
      }
}

DI void gemm_phase(int epi, const bf16* __restrict__ A, const bf16* __restrict__ Bt, int Mtiles, int N, int K, int nquads, EpiArgs ea, char* ldsc) {
  bf16* shm = (bf16*)ldsc;
#define SA(b, h) (shm + ((b) * 2 + (h)) * HT)
#define SB(b, h) (shm + (4 + (b) * 2 + (h)) * HT)
#define STAGE(P, BASE, br, kt) do { const char* _g = (const char*)((BASE) + (size_t)(br) * K + (size_t)(kt) * BK); \
    __builtin_amdgcn_global_load_lds((const unsigned*)(_g + tbyte), (__attribute__((address_space(3))) unsigned*)((char*)(P) + wbase), 16, 0, 0); \
    __builtin_amdgcn_global_load_lds((const unsigned*)(_g + (size_t)128 * K + tbyte), (__attribute__((address_space(3))) unsigned*)((char*)(P) + wbase + 8192), 16, 0, 0); } while (0)
#define LDA(dst, b, h) _Pragma("unroll") for (int m = 0; m < 4; ++m) _Pragma("unroll") for (int k = 0; k < 2; ++k) \
    dst[m][k] = *reinterpret_cast<const bf16x8*>((char*)SA(b, h) + lds_byte(wr * 64 + m * 16 + fr, k * 32 + fq * 8))
#define LDB(dst, b, h) _Pragma("unroll") for (int n = 0; n < 2; ++n) _Pragma("unroll") for (int k = 0; k < 2; ++k) \
    dst[n][k] = *reinterpret_cast<const bf16x8*>((char*)SB(b, h) + lds_byte(wc * 32 + n * 16 + fr, k * 32 + fq * 8))
#define MMA(ai, bj, At_, Bt_) do { __builtin_amdgcn_s_setprio(1); \
    _Pragma("unroll") for (int m = 0; m < 4; ++m) _Pragma("unroll") for (int n = 0; n < 2; ++n) _Pragma("unroll") for (int k = 0; k < 2; ++k) \
      acc[ai][bj][m][n] = __builtin_amdgcn_mfma_f32_16x16x32_bf16(At_[m][k], Bt_[n][k], acc[ai][bj][m][n], 0, 0, 0); \
    __builtin_amdgcn_s_setprio(0); } while (0)
#define WAIT_V(n) asm volatile("s_waitcnt vmcnt(" #n ")" ::: "memory")
#define WAIT_L(n) asm volatile("s_waitcnt lgkmcnt(" #n ")" ::: "memory")
#define BAR __builtin_amdgcn_s_barrier()
#define SCHED __builtin_amdgcn_sched_barrier(0)
  const int nN = N / BM, nwg = Mtiles * nN;
  const int nt = K / BK;
  for (int tile = blockIdx.x; tile < nwg + nquads; tile += gridDim.x) {
    const unsigned tid = otid();
    const int wid = __builtin_amdgcn_readfirstlane(tid >> 6), lane = tid & 63, wr = wid >> 2, wc = wid & 3, fr = lane & 15, fq = lane >> 4;
    const unsigned wbase = (unsigned)wid * 1024u;
    unsigned tbyte;
    { int r_, c_; stage_rc((int)(tid * 16), r_, c_); tbyte = (unsigned)(r_ * K + c_) * 2u; }
    const bool quad = tile >= nwg;
    int brow, bcol;
    if (!quad) {
      int wgid = tile;
      { const int q = nwg / 8, r = nwg % 8, xcd = wgid % 8, off = wgid / 8; wgid = (xcd < r ? xcd * (q + 1) : r * (q + 1) + (xcd - r) * q) + off; }
      const int nig = 4 * nN, gid = wgid / nig, fm = gid * 4, gsz = min(Mtiles - fm, 4);
      const int pm = fm + ((wgid % nig) % gsz), pn = (wgid % nig) / gsz;
      brow = __builtin_amdgcn_readfirstlane(pm * BM); bcol = __builtin_amdgcn_readfirstlane(pn * BM);
    } else {
      const int qt = tile - nwg;
      brow = __builtin_amdgcn_readfirstlane(Mtiles * BM + (qt & 3) * HALF); bcol = __builtin_amdgcn_readfirstlane((qt >> 2) * HALF);
    }
    f32x4 acc[2][2][4][2];
#pragma unroll
    for (int a = 0; a < 2; ++a)
#pragma unroll
      for (int b = 0; b < 2; ++b)
#pragma unroll
        for (int m = 0; m < 4; ++m)
#pragma unroll
          for (int n = 0; n < 2; ++n) acc[a][b][m][n] = f32x4{0.f, 0.f, 0.f, 0.f};
    bf16x8 At[4][2], B0[2][2], B1[2][2];
    if (quad) {
#define QSTAGE(s_, kt_) do { STAGE(shm + (s_) * HT, A, brow, kt_); STAGE(shm + (4 + (s_)) * HT, Bt, bcol, kt_); } while (0)
      WAIT_V(0);
      QSTAGE(0, 0); QSTAGE(1, 1); QSTAGE(2, 2);
      for (int kt = 0; kt < nt; ++kt) {
        const int sl = kt & 3;
        if (kt + 3 < nt) { QSTAGE((kt + 3) & 3, kt + 3); WAIT_V(12); }
        else if (kt + 2 < nt) WAIT_V(8);
        else if (kt + 1 < nt) WAIT_V(4);
        else WAIT_V(0);
        BAR;
#pragma unroll
        for (int m = 0; m < 4; ++m)
#pragma unroll
          for (int k = 0; k < 2; ++k) At[m][k] = *reinterpret_cast<const bf16x8*>((char*)(shm + sl * HT) + lds_byte(wr * 64 + m * 16 + fr, k * 32 + fq * 8));
#pragma unroll
        for (int n = 0; n < 2; ++n)
#pragma unroll
          for (int k = 0; k < 2; ++k) B0[n][k] = *reinterpret_cast<const bf16x8*>((char*)(shm + (4 + sl) * HT) + lds_byte(wc * 32 + n * 16 + fr, k * 32 + fq * 8));
        WAIT_L(0); MMA(0, 0, At, B0);
        BAR;
      }
#undef QSTAGE
    } else {
    STAGE(SB(0, 0), Bt, bcol, 0); STAGE(SA(0, 0), A, brow, 0);
    STAGE(SB(0, 1), Bt, bcol + HALF, 0); STAGE(SA(0, 1), A, brow + HALF, 0);
    if (wr == 1) BAR;
    WAIT_V(4); BAR;
    STAGE(SB(1, 0), Bt, bcol, 1); STAGE(SA(1, 0), A, brow, 1); STAGE(SB(1, 1), Bt, bcol + HALF, 1);
    WAIT_V(6); BAR;
    for (int t = 0; t < nt - 2; t += 2) {
      LDB(B0, 0, 0); SCHED; LDA(At, 0, 0); STAGE(SA(1, 1), A, brow + HALF, t + 1);
      WAIT_L(8); BAR; WAIT_L(0); MMA(0, 0, At, B0); BAR; SCHED;
      LDB(B1, 0, 1); STAGE(SB(0, 0), Bt, bcol, t + 2);
      BAR; WAIT_L(0); MMA(0, 1, At, B1); BAR;
      LDA(At, 0, 1); STAGE(SA(0, 0), A, brow, t + 2);
      BAR; WAIT_L(0); MMA(1, 0, At, B0); BAR; SCHED;
      STAGE(SB(0, 1), Bt, bcol + HALF, t + 2);
      WAIT_V(6); BAR; MMA(1, 1, At, B1); BAR;
      LDB(B0, 1, 0); SCHED; LDA(At, 1, 0); STAGE(SA(0, 1), A, brow + HALF, t + 2);
      WAIT_L(8); BAR; WAIT_L(0); MMA(0, 0, At, B0); BAR; SCHED;
      LDB(B1, 1, 1); STAGE(SB(1, 0), Bt, bcol, t + 3);
      BAR; WAIT_L(0); MMA(0, 1, At, B1); BAR;
      LDA(At, 1, 1); STAGE(SA(1, 0), A, brow, t + 3);
      BAR; WAIT_L(0); MMA(1, 0, At, B0); BAR; SCHED;
      STAGE(SB(1, 1), Bt, bcol + HALF, t + 3);
      WAIT_V(6); BAR; MMA(1, 1, At, B1); BAR;
    }
    { LDB(B0, 0, 0); LDA(At, 0, 0); STAGE(SA(1, 1), A, brow + HALF, nt - 1);
      BAR; WAIT_L(0); MMA(0, 0, At, B0); BAR;
      LDB(B1, 0, 1); BAR; WAIT_L(0); MMA(0, 1, At, B1); BAR;
      LDA(At, 0, 1); WAIT_V(4); BAR; WAIT_L(0); MMA(1, 0, At, B0); MMA(1, 1, At, B1); BAR; }
    { LDB(B0, 1, 0); LDA(At, 1, 0); WAIT_V(2); BAR; WAIT_L(0); MMA(0, 0, At, B0); BAR;
      LDB(B1, 1, 1); WAIT_V(0); BAR; WAIT_L(0); MMA(0, 1, At, B1); BAR;
      LDA(At, 1, 1); BAR; WAIT_L(0); MMA(1, 0, At, B0); MMA(1, 1, At, B1); BAR; }
    if (wr == 0) BAR;
    }
    if (epi == EPI_STORE) gemm_epilogue<EPI_STORE>(acc, ea, brow, bcol, quad);
    else if (epi == EPI_ROPE) gemm_epilogue<EPI_ROPE>(acc, ea, brow, bcol, quad);
    else if (epi == EPI_SWIGLU) gemm_epilogue<EPI_SWIGLU>(acc, ea, brow, bcol, quad);
    else gemm_epilogue<EPI_GELU>(acc, ea, brow, bcol, quad);
  }
#undef SA
#undef SB
#undef STAGE
#undef LDA
#undef LDB
#undef MMA
}

constexpr int KVBLK = 64;
constexpr size_t SHM_V = KVBLK * 128 * 2, SHM_K = KVBLK * 64 * 2;
constexpr float ATT_SCALE = 0.125f, ATT_THR = 8.f;
constexpr float THR2 = ATT_THR * 1.4426950408889634f;
#ifndef ATT_SUM_BIG
#define ATT_SUM_BIG 65536.f
#endif
constexpr float SUM_BIG = ATT_SUM_BIG;
#define KSWZ(row, colB) ((row) * 128 + ((colB) ^ ((((row) >> 1) & 7) << 4)))
#define SBAR() __builtin_amdgcn_sched_barrier(0)
DI int crow(int r, int hi) { return (r & 3) + 8 * (r >> 2) + 4 * hi; }

DI void qkt(f32x16& p0, f32x16& p1, const char* Ks, const char* qls, const f32x16& negm, int r32, int hi) {
  bf16x8 qr[4];
#pragma unroll
  for (int d0 = 0; d0 < 4; ++d0) qr[d0] = *reinterpret_cast<const bf16x8*>(qls + d0 * 1024);
#pragma unroll
  for (int d0 = 0; d0 < 4; ++d0) { const int cb = (d0 * 16 + hi * 8) * 2;
    const bf16x8 b0 = *reinterpret_cast<const bf16x8*>(Ks + KSWZ(r32, cb));
    const bf16x8 b1 = *reinterpret_cast<const bf16x8*>(Ks + KSWZ(32 + r32, cb));
    if (d0 == 0) { p0 = __builtin_amdgcn_mfma_f32_32x32x16_bf16(b0, qr[0], negm, 0, 0, 0); p1 = __builtin_amdgcn_mfma_f32_32x32x16_bf16(b1, qr[0], negm, 0, 0, 0); }
    else { p0 = __builtin_amdgcn_mfma_f32_32x32x16_bf16(b0, qr[d0], p0, 0, 0, 0); p1 = __builtin_amdgcn_mfma_f32_32x32x16_bf16(b1, qr[d0], p1, 0, 0, 0); } }
}
template <bool FIRST>
DI void partialSM(f32x16& p0, f32x16& p1, float& m_reg, f32x16& negm, float& alpha, const char* Ks, const char* qls, int r32, int hi) {
  float pmax = p0[0];
#pragma unroll
  for (int r = 1; r < 16; ++r) pmax = fmaxf(pmax, p0[r]);
#pragma unroll
  for (int r = 0; r < 16; ++r) pmax = fmaxf(pmax, p1[r]);
  { auto rr = __builtin_amdgcn_permlane32_swap(__float_as_uint(pmax), __float_as_uint(pmax), false, false);
    pmax = fmaxf(__uint_as_float(rr[0]), __uint_as_float(rr[1])); }
  if (FIRST) {
    alpha = 1.f; m_reg += pmax;
    const float nm = -m_reg;
#pragma unroll
    for (int r = 0; r < 16; ++r) { p0[r] -= pmax; p1[r] -= pmax; negm[r] = nm; }
#pragma unroll
    for (int r = 0; r < 16; ++r) p0[r] = __builtin_amdgcn_exp2f(p0[r]);
  } else {
#pragma unroll
    for (int r = 0; r < 16; ++r) p0[r] = __builtin_amdgcn_exp2f(p0[r]);
    asm volatile("" :: "v"(p0[0]), "v"(p0[1]), "v"(p0[2]), "v"(p0[3]), "v"(p0[4]), "v"(p0[5]), "v"(p0[6]), "v"(p0[7]),
                 "v"(p0[8]), "v"(p0[9]), "v"(p0[10]), "v"(p0[11]), "v"(p0[12]), "v"(p0[13]), "v"(p0[14]), "v"(p0[15]));
    if (__builtin_expect(__all(pmax <= THR2), 1)) { alpha = 1.f; }
    else {
      const float d = fmaxf(pmax, 0.f);
      alpha = __builtin_amdgcn_exp2f(-d);
      m_reg += d;
      const float nm = -m_reg;
#pragma unroll
      for (int r = 0; r < 16; ++r) negm[r] = nm;
      qkt(p0, p1, Ks, qls, negm, r32, hi);
#pragma unroll
      for (int r = 0; r < 16; ++r) p0[r] = __builtin_amdgcn_exp2f(p0[r]);
    }
  }
}
DI void finishSM(f32x16& p0, f32x16& p1, float alpha, float& l_reg, bf16x8& pa0, bf16x8& pa1, bf16x8& pa2, bf16x8& pa3) {
#pragma unroll
  for (int r = 0; r < 16; ++r) p1[r] = __builtin_amdgcn_exp2f(p1[r]);
  float ps = 0;
#pragma unroll
  for (int r = 0; r < 16; ++r) ps += p0[r];
#pragma unroll
  for (int r = 0; r < 16; ++r) ps += p1[r];
  { auto rr = __builtin_amdgcn_permlane32_swap(__float_as_uint(ps), __float_as_uint(ps), false, false);
    ps = __uint_as_float(rr[0]) + __uint_as_float(rr[1]); }
  l_reg = l_reg * alpha + ps;
#define PK4(P, BASE, OUT) do { u32x4 w = {cvtpk(P[BASE + 0], P[BASE + 1]), cvtpk(P[BASE + 2], P[BASE + 3]), cvtpk(P[BASE + 4], P[BASE + 5]), cvtpk(P[BASE + 6], P[BASE + 7])}; \
    OUT = *reinterpret_cast<bf16x8*>(&w); } while (0)
  PK4(p0, 0, pa0); PK4(p0, 8, pa1); PK4(p1, 0, pa2); PK4(p1, 8, pa3);
#undef PK4
}
DI int v_st(int k, int c) { const int kk = k; return ((kk >> 3) * 4 + (c >> 5)) * 512 + ((kk & 7) * 32 + (c & 31)) * 2; }
DI int v_rd_base(int lane) { return ((lane & 3) << 3) | (((lane >> 2) & 3) << 6) | (((lane >> 4) & 1) << 5) | (((lane >> 5) & 1) << 8); }
constexpr int v_rd_off(int d0, int ks, int half) { return d0 * 512 + ks * 4096 + half * 2048; }
template <int OFF> DI s16x4 tr_read(int vb) {
  s16x4 r; asm volatile("ds_read_b64_tr_b16 %0, %1 offset:%2" : "=&v"(r) : "v"(vb), "i"(OFF) : "memory"); return r;
}
#define PV_READ(S, KS) s16x4 l##S##0 = tr_read<v_rd_off(0, KS, 0)>(vb), h##S##0 = tr_read<v_rd_off(0, KS, 1)>(vb), l##S##1 = tr_read<v_rd_off(1, KS, 0)>(vb), h##S##1 = tr_read<v_rd_off(1, KS, 1)>(vb), \
    l##S##2 = tr_read<v_rd_off(2, KS, 0)>(vb), h##S##2 = tr_read<v_rd_off(2, KS, 1)>(vb), l##S##3 = tr_read<v_rd_off(3, KS, 0)>(vb), h##S##3 = tr_read<v_rd_off(3, KS, 1)>(vb)
#define PV_WAIT(S, N) asm volatile("s_waitcnt lgkmcnt(" #N ")" : "+v"(l##S##0), "+v"(h##S##0), "+v"(l##S##1), "+v"(h##S##1), "+v"(l##S##2), "+v"(h##S##2), "+v"(l##S##3), "+v"(h##S##3) :: "memory")
#define PK(L, H) (bf16x8){L[0], L[1], L[2], L[3], H[0], H[1], H[2], H[3]}
#define PV_MMA(S, PA) do { o[0] = __builtin_amdgcn_mfma_f32_32x32x16_bf16(PA, PK(l##S##0, h##S##0), o[0], 0, 0, 0); o[1] = __builtin_amdgcn_mfma_f32_32x32x16_bf16(PA, PK(l##S##1, h##S##1), o[1], 0, 0, 0); \
    o[2] = __builtin_amdgcn_mfma_f32_32x32x16_bf16(PA, PK(l##S##2, h##S##2), o[2], 0, 0, 0); o[3] = __builtin_amdgcn_mfma_f32_32x32x16_bf16(PA, PK(l##S##3, h##S##3), o[3], 0, 0, 0); } while (0)
DI void pv_d0(f32x16* o, int vb, bf16x8 pa0, bf16x8 pa1, bf16x8 pa2, bf16x8 pa3) {
  PV_READ(A, 0); PV_READ(B, 1);
  PV_WAIT(A, 8);
  PV_MMA(A, pa0);
  PV_READ(C, 2);
  PV_WAIT(B, 8);
  PV_MMA(B, pa1);
  PV_READ(D, 3);
  PV_WAIT(C, 8);
  PV_MMA(C, pa2);
  PV_WAIT(D, 0);
  PV_MMA(D, pa3);
}
#undef PV_READ
#undef PV_WAIT
#undef PV_MMA
#undef PK

DI void pack_p(const f32x16& p0, const f32x16& p1, bf16x8& pa0, bf16x8& pa1, bf16x8& pa2, bf16x8& pa3) {
#define PK4(P, BASE, OUT) do { u32x4 w = {cvtpk(P[BASE + 0], P[BASE + 1]), cvtpk(P[BASE + 2], P[BASE + 3]), cvtpk(P[BASE + 4], P[BASE + 5]), cvtpk(P[BASE + 6], P[BASE + 7])}; \
    OUT = *reinterpret_cast<bf16x8*>(&w); } while (0)
  PK4(p0, 0, pa0); PK4(p0, 8, pa1); PK4(p1, 0, pa2); PK4(p1, 8, pa3);
#undef PK4
}
DI void attn_item(const bf16* __restrict__ Qb, const bf16* __restrict__ Kcol, const bf16* __restrict__ Vcol, int kctx, int klat,
                  bf16* __restrict__ Ob, int nkeys, char* lds) {
  const int tid = (int)otid(), wid = tid >> 6, lane = tid & 63, r32 = lane & 31, hi = lane >> 5;
  char* V_lds = lds; char* K_lds = lds + 2 * SHM_V;
  float* ws = (float*)(lds + 2 * SHM_V + 2 * SHM_K) + wid * 64; float* li_l = ws; float* al_l = ws + 32;
  float m_reg = 0.f, l_reg = 0; f32x16 o[4] = {}; f32x16 negm = {};
  char* qr = lds + 2 * SHM_V + 2 * SHM_K + 2048 + wid * 4096 + lane * 16;
  const bf16* Qw = Qb + (size_t)(wid * 32 + r32) * QKVW + hi * 8;
#pragma unroll
  for (int d0 = 0; d0 < 4; ++d0) *reinterpret_cast<bf16x8*>(qr + d0 * 1024) = *reinterpret_cast<const bf16x8*>(Qw + d0 * 16);
  const int sr = tid >> 4, sc = (tid & 15) * 8, vst0 = v_st(sr, sc), vst1 = v_st(32 + sr, sc);
  const int kr = tid >> 3, kc = (tid & 7) * 8, kst = KSWZ(kr, kc * 2);
  const unsigned voV = (unsigned)(sr * QKVW + sc) * 2u, voK = (unsigned)(kr * QKVW + kc) * 2u;
  const int vb0 = (int)(uintptr_t)V_lds + v_rd_base(lane);
  bf16x8 vsA0, vsA1, ksA, vsB0, vsB1, ksB;
#define KROW(k0) ((k0) < CTXL ? kctx + (k0) : klat + (k0) - CTXL)
#define SLOAD(S, k0) do { const size_t _kr = (size_t)__builtin_amdgcn_readfirstlane(KROW(k0)); \
    const char* vb_ = (const char*)(Vcol + _kr * QKVW); const char* kb_ = (const char*)(Kcol + _kr * QKVW);     \
    vs##S##0 = *reinterpret_cast<const bf16x8*>(vb_ + voV); vs##S##1 = *reinterpret_cast<const bf16x8*>(vb_ + (size_t)32 * QKVW * 2 + voV); \
    ks##S = *reinterpret_cast<const bf16x8*>(kb_ + voK); } while (0)
#define SWRITE(b, S) do { *(bf16x8*)(V_lds + (b) * SHM_V + vst0) = vs##S##0; *(bf16x8*)(V_lds + (b) * SHM_V + vst1) = vs##S##1; \
    *(bf16x8*)(K_lds + (b) * SHM_K + kst) = ks##S; } while (0)
#define SWAIT() asm volatile("s_waitcnt vmcnt(3)" ::: "memory")
#define RESC(a) do { if (__any((a) < 1.f)) { if (hi == 0) al_l[r32] = (a); asm volatile("s_waitcnt lgkmcnt(0)" ::: "memory"); \
    _Pragma("unroll") for (int d = 0; d < 4; ++d) _Pragma("unroll") for (int r = 0; r < 16; ++r) o[d][r] *= al_l[crow(r, hi)]; } } while (0)
  f32x16 pA0, pA1, pB0, pB1; float alA, alB; bf16x8 pa0, pa1, pa2, pa3; const int NT = nkeys / KVBLK;
  SLOAD(A, 0); asm volatile("s_waitcnt vmcnt(0)" ::: "memory"); SWRITE(0, A); __syncthreads();
  qkt(pA0, pA1, K_lds, qr, negm, r32, hi); partialSM<true>(pA0, pA1, m_reg, negm, alA, K_lds, qr, r32, hi);
  SLOAD(B, KVBLK); if (2 < NT) SLOAD(A, 2 * KVBLK);
  SWAIT(); SWRITE(1, B); __syncthreads();
  for (int j = 1; j + 1 < NT; j += 2) {
    SBAR(); qkt(pB0, pB1, K_lds + SHM_K, qr, negm, r32, hi);
    finishSM(pA0, pA1, alA, l_reg, pa0, pa1, pa2, pa3); SBAR();
    SLOAD(B, (j + 2) * KVBLK); SBAR();
    pv_d0(o, vb0, pa0, pa1, pa2, pa3); partialSM<false>(pB0, pB1, m_reg, negm, alB, K_lds + SHM_K, qr, r32, hi);
    __syncthreads(); SWAIT(); SWRITE(0, A);
    RESC(alB); __syncthreads();
    SBAR(); qkt(pA0, pA1, K_lds, qr, negm, r32, hi);
    finishSM(pB0, pB1, alB, l_reg, pa0, pa1, pa2, pa3); SBAR();
    if (j + 3 < NT) SLOAD(A, (j + 3) * KVBLK); SBAR();
    pv_d0(o, vb0 + (int)SHM_V, pa0, pa1, pa2, pa3); partialSM<false>(pA0, pA1, m_reg, negm, alA, K_lds, qr, r32, hi);
    __syncthreads(); SWAIT(); SWRITE(1, B);
    RESC(alA); __syncthreads();
  }
  SBAR(); qkt(pB0, pB1, K_lds + SHM_K, qr, negm, r32, hi);
  finishSM(pA0, pA1, alA, l_reg, pa0, pa1, pa2, pa3); SBAR();
  pv_d0(o, vb0, pa0, pa1, pa2, pa3); partialSM<false>(pB0, pB1, m_reg, negm, alB, K_lds + SHM_K, qr, r32, hi);
  __syncthreads(); RESC(alB);
  finishSM(pB0, pB1, alB, l_reg, pa0, pa1, pa2, pa3); SBAR();
  pv_d0(o, vb0 + (int)SHM_V, pa0, pa1, pa2, pa3);
  if (hi == 0) li_l[r32] = l_reg; asm volatile("s_waitcnt lgkmcnt(0)" ::: "memory");
  float rli[16];
#pragma unroll
  for (int r = 0; r < 16; ++r) rli[r] = __builtin_amdgcn_rcpf(li_l[crow(r, hi)]);
  bf16* Ow = Ob + (size_t)(wid * 32) * 2048;
#pragma unroll
  for (int r = 0; r < 16; ++r) { const int orow = crow(r, hi);
#pragma unroll
    for (int d0 = 0; d0 < 4; ++d0) Ow[(size_t)orow * 2048 + d0 * 32 + r32] = __float2bfloat16(o[d0][r] * rli[r]); }
  __syncthreads();
#undef SLOAD
#undef SWRITE
#undef SWAIT
#undef RESC
#undef KROW
}

DI bool attn_item_fast(const bf16* __restrict__ Qb, const bf16* __restrict__ Kcol, const bf16* __restrict__ Vcol, int kctx, int klat,
                  bf16* __restrict__ Ob, int nkeys, char* lds) {
  const int tid = (int)otid(), wid = tid >> 6, lane = tid & 63, r32 = lane & 31, hi = lane >> 5;
  char* V_lds = lds; char* K_lds = lds + 2 * SHM_V;
  float* ws = (float*)(lds + 2 * SHM_V + 2 * SHM_K) + wid * 64; float* li_l = ws; float* al_l = ws + 32;
  float m_reg = 0.f, l_reg = 0; f32x16 o[4] = {}; f32x16 negm = {};
  char* qr = lds + 2 * SHM_V + 2 * SHM_K + 2048 + wid * 4096 + lane * 16;
  const bf16* Qw = Qb + (size_t)(wid * 32 + r32) * QKVW + hi * 8;
#pragma unroll
  for (int d0 = 0; d0 < 4; ++d0) *reinterpret_cast<bf16x8*>(qr + d0 * 1024) = *reinterpret_cast<const bf16x8*>(Qw + d0 * 16);
  const int sr = tid >> 4, sc = (tid & 15) * 8, vst0 = v_st(sr, sc), vst1 = v_st(32 + sr, sc);
  const int kr = tid >> 3, kc = (tid & 7) * 8, kst = KSWZ(kr, kc * 2);
  const unsigned voV = (unsigned)(sr * QKVW + sc) * 2u, voK = (unsigned)(kr * QKVW + kc) * 2u;
  const int vb0 = (int)(uintptr_t)V_lds + v_rd_base(lane);
  bf16x8 vsA0, vsA1, ksA, vsB0, vsB1, ksB;
#define KROW(k0) ((k0) < CTXL ? kctx + (k0) : klat + (k0) - CTXL)
#define SLOAD(S, k0) do { const size_t _kr = (size_t)__builtin_amdgcn_readfirstlane(KROW(k0)); \
    const char* vb_ = (const char*)(Vcol + _kr * QKVW); const char* kb_ = (const char*)(Kcol + _kr * QKVW);     \
    vs##S##0 = *reinterpret_cast<const bf16x8*>(vb_ + voV); vs##S##1 = *reinterpret_cast<const bf16x8*>(vb_ + (size_t)32 * QKVW * 2 + voV); \
    ks##S = *reinterpret_cast<const bf16x8*>(kb_ + voK); } while (0)
#define SWRITE(b, S) do { *(bf16x8*)(V_lds + (b) * SHM_V + vst0) = vs##S##0; *(bf16x8*)(V_lds + (b) * SHM_V + vst1) = vs##S##1; \
    *(bf16x8*)(K_lds + (b) * SHM_K + kst) = ks##S; } while (0)
#define SWAIT() asm volatile("s_waitcnt vmcnt(3)" ::: "memory")
#define RESC(a) do { if (__any((a) < 1.f)) { if (hi == 0) al_l[r32] = (a); asm volatile("s_waitcnt lgkmcnt(0)" ::: "memory"); \
    _Pragma("unroll") for (int d = 0; d < 4; ++d) _Pragma("unroll") for (int r = 0; r < 16; ++r) o[d][r] *= al_l[crow(r, hi)]; } } while (0)
  f32x16 pA0, pA1, pB0, pB1; bf16x8 pa0, pa1, pa2, pa3; const int NT = nkeys / KVBLK; float alA; bool bad_ = false;
  char* const K0 = K_lds; char* const K1 = K_lds + SHM_K;
  float hs = 0.f;
  bf16x8 na0, na1;
#define PKH(P, BASE, OUT) do { u32x4 w_ = {cvtpk(P[BASE + 0], P[BASE + 1]), cvtpk(P[BASE + 2], P[BASE + 3]), cvtpk(P[BASE + 4], P[BASE + 5]), cvtpk(P[BASE + 6], P[BASE + 7])}; \
    OUT = *reinterpret_cast<bf16x8*>(&w_); } while (0)
#define SCALE_PK(X, AL) do { u32x4 w_ = *reinterpret_cast<u32x4*>(&X); _Pragma("unroll") for (int q_ = 0; q_ < 4; ++q_) w_[q_] = cvtpk(bf_lo(w_[q_]) * (AL), bf_hi(w_[q_]) * (AL)); \
    X = *reinterpret_cast<bf16x8*>(&w_); } while (0)
#define EXP_FIRST(P0) do { _Pragma("unroll") for (int r = 0; r < 16; ++r) P0[r] = __builtin_amdgcn_exp2f(P0[r]); hs = 0.f; _Pragma("unroll") for (int r = 0; r < 16; ++r) hs += P0[r]; \
    PKH(P0, 0, na0); PKH(P0, 8, na1); } while (0)
#define ROWSUM(P1, PS) do { PS = hs; _Pragma("unroll") for (int r = 0; r < 16; ++r) PS += P1[r]; \
    auto rr_ = __builtin_amdgcn_permlane32_swap(__float_as_uint(PS), __float_as_uint(PS), false, false); PS = __uint_as_float(rr_[0]) + __uint_as_float(rr_[1]); } while (0)
#define LAZY(P1, HASQ, Q0, Q1, PS) do { \
    bad_ |= !(PS < 1.2676506e30f); \
    const float d_ = (PS > SUM_BIG) ? (__builtin_amdgcn_logf(PS) - 4.f) : 0.f; \
    const float al_ = __builtin_amdgcn_exp2f(-d_); m_reg += d_; const float nm_ = -m_reg; \
    SCALE_PK(na0, al_); SCALE_PK(na1, al_); \
    _Pragma("unroll") for (int r = 0; r < 16; ++r) { negm[r] = nm_; P1[r] *= al_; if (HASQ) { Q0[r] -= d_; Q1[r] -= d_; } } \
    l_reg = (l_reg + PS) * al_; PS = 0.f; \
    if (hi == 0) al_l[r32] = al_; asm volatile("s_waitcnt lgkmcnt(0)" ::: "memory"); \
    _Pragma("unroll") for (int d4 = 0; d4 < 4; ++d4) _Pragma("unroll") for (int r = 0; r < 16; ++r) o[d4][r] *= al_l[crow(r, hi)]; } while (0)
#define FINISH(P1, HASQ, Q0, Q1) do { float ps_; \
    _Pragma("unroll") for (int r = 0; r < 16; ++r) P1[r] = __builtin_amdgcn_exp2f(P1[r]); \
    ROWSUM(P1, ps_); \
    if (__builtin_expect(!__all(ps_ <= SUM_BIG), 0)) LAZY(P1, HASQ, Q0, Q1, ps_); \
    l_reg += ps_; pa0 = na0; pa1 = na1; PKH(P1, 0, pa2); PKH(P1, 8, pa3); } while (0)
  SLOAD(A, 0); asm volatile("s_waitcnt vmcnt(0)" ::: "memory"); SWRITE(0, A); __syncthreads();
  qkt(pA0, pA1, K0, qr, negm, r32, hi); partialSM<true>(pA0, pA1, m_reg, negm, alA, K0, qr, r32, hi);
  { hs = 0.f; _Pragma("unroll") for (int r = 0; r < 16; ++r) hs += pA0[r]; PKH(pA0, 0, na0); PKH(pA0, 8, na1); }
  SLOAD(B, KVBLK); if (2 < NT) SLOAD(A, 2 * KVBLK);
  SWAIT(); SWRITE(1, B); __syncthreads();
  for (int j = 1; j + 1 < NT; j += 2) {
    SBAR(); qkt(pB0, pB1, K1, qr, negm, r32, hi);
    FINISH(pA1, true, pB0, pB1); SBAR();
    SLOAD(B, (j + 2) * KVBLK); SBAR();
    pv_d0(o, vb0, pa0, pa1, pa2, pa3); EXP_FIRST(pB0);
    __syncthreads(); SWAIT(); SWRITE(0, A); __syncthreads();
    SBAR(); qkt(pA0, pA1, K0, qr, negm, r32, hi);
    FINISH(pB1, true, pA0, pA1); SBAR();
    if (j + 3 < NT) SLOAD(A, (j + 3) * KVBLK); SBAR();
    pv_d0(o, vb0 + (int)SHM_V, pa0, pa1, pa2, pa3); EXP_FIRST(pA0);
    __syncthreads(); SWAIT(); SWRITE(1, B); __syncthreads();
  }
  SBAR(); qkt(pB0, pB1, K1, qr, negm, r32, hi);
  FINISH(pA1, true, pB0, pB1); SBAR();
  pv_d0(o, vb0, pa0, pa1, pa2, pa3); EXP_FIRST(pB0);
  FINISH(pB1, false, pB0, pB1); SBAR();
  pv_d0(o, vb0 + (int)SHM_V, pa0, pa1, pa2, pa3);
#undef PKH
#undef SCALE_PK
  bad_ = bad_ || !(l_reg < 1.2676506e30f) || !(l_reg > 0.f);
#undef EXP_FIRST
#undef ROWSUM
#undef LAZY
#undef FINISH
  if (hi == 0) li_l[r32] = l_reg; asm volatile("s_waitcnt lgkmcnt(0)" ::: "memory");
  float rli[16];
#pragma unroll
  for (int r = 0; r < 16; ++r) rli[r] = __builtin_amdgcn_rcpf(li_l[crow(r, hi)]);
  bf16* Ow = Ob + (size_t)(wid * 32) * 2048;
#pragma unroll
  for (int r = 0; r < 16; ++r) { const int orow = crow(r, hi);
#pragma unroll
    for (int d0 = 0; d0 < 4; ++d0) Ow[(size_t)orow * 2048 + d0 * 32 + r32] = __float2bfloat16(o[d0][r] * rli[r]); }
  return __syncthreads_or(bad_ ? 1 : 0) != 0;
#undef SLOAD
#undef SWRITE
#undef SWAIT
#undef RESC
#undef KROW
}

DI void phase_attention(const Params& p, bool with_ctx, char* lds) {
  const bf16* qkv = (const bf16*)(p.ws + OFF_A);
  bf16* O16 = (bf16*)(p.ws + OFF_B);
  const int nitems = 2048 + (with_ctx ? 32 : 0);
  for (int it = blockIdx.x; it < nitems; it += gridDim.x) {
    int b, qh, qrow0, klat, nkeys;
    if (it < 2048) {
      int combo, qblk;
      if (gridDim.x == 256) { const int r = it >> 8, bid = it & 255, xcd = bid & 7, slot = bid >> 3; combo = xcd * 4 + (r >> 1); qblk = (r & 1) * 32 + slot; }
      else { combo = it >> 6; qblk = it & 63; }
      b = combo >> 4; qh = combo & 15; qrow0 = b * SEQ + qblk * 256; klat = b * SEQ; nkeys = SEQ + CTXL;
    } else {
      const int c = it - 2048; b = c >> 4; qh = c & 15; qrow0 = NLAT + b * CTXL; klat = 0; nkeys = CTXL;
    }
    const bf16* Qb = qkv + (size_t)qrow0 * QKVW + qh * 64; const bf16* Kc = qkv + 1024 + qh * 64; const bf16* Vc = qkv + 2048 + (qh >> 1) * 128;
    bf16* Ob = O16 + (size_t)qrow0 * 2048 + qh * 128;
#ifdef ATT_FORCE_SAFE
    const bool bad = attn_item_fast(Qb, Kc, Vc, NLAT + b * CTXL, klat, Ob, nkeys, lds) || true;
#else
    const bool bad = attn_item_fast(Qb, Kc, Vc, NLAT + b * CTXL, klat, Ob, nkeys, lds);
#endif
    if (bad) attn_item(Qb, Kc, Vc, NLAT + b * CTXL, klat, Ob, nkeys, lds);
  }
}

constexpr int SPLD = 136;
#define SVROW(E) ((((E) & 7) << 4) | ((E) >> 3))
DI void phase_spatial(const Params& p, int nchunks, int j, char* ldsc) {
  const bf16* Z = (const bf16*)(p.ws + OFF_A);
  bf16* Aout = (bf16*)(p.ws + OFF_B);
  const bf16* Wsp = (const bf16*)(p.ws + OFF_WSP) + (size_t)j * 8 * 128 * 128;
  const int t = (int)otid(), wid = t >> 6, lane = t & 63, fr = lane & 15, fq = lane >> 4;
  bf16* sW = (bf16*)ldsc;
  bf16* sV = sW + 128 * SPLD;
  float* sMu = (float*)(sV + 128 * SPLD);
  float* sRs = sMu + 128;
  for (int ch = blockIdx.x; ch < nchunks; ch += gridDim.x) {
    const int r0 = ch * 128;
    for (int i = 0; i < 16; ++i) {
      const int q = wid * 16 + i;
      const bf16* vr = Z + (size_t)(r0 + q) * 2048 + 1024 + lane * 16;
      const u32x4 a = *reinterpret_cast<const u32x4*>(vr), b = *reinterpret_cast<const u32x4*>(vr + 8);
      float f[16];
#pragma unroll
      for (int k = 0; k < 4; ++k) { f[2 * k] = bf_lo(a[k]); f[2 * k + 1] = bf_hi(a[k]); f[8 + 2 * k] = bf_lo(b[k]); f[8 + 2 * k + 1] = bf_hi(b[k]); }
      float s = 0.f;
#pragma unroll
      for (int k = 0; k < 16; ++k) s += f[k];
      s = wave_sum(s);
      const float mu = s * (1.f / 1024.f);
      float vs = 0.f;
#pragma unroll
      for (int k = 0; k < 16; ++k) { const float d = f[k] - mu; vs += d * d; }
      vs = wave_sum(vs);
      if (lane == 0) { sMu[q] = mu; sRs[q] = rsqrtf(vs * (1.f / 1024.f) + EPS); }
    }
    for (int g = 0; g < 8; ++g) {
      __syncthreads();
      {
        const int pr = t >> 2, qc = (t & 3) * 32;
        const bf16* src = Wsp + (size_t)g * 16384 + pr * 128 + qc;
#pragma unroll
        for (int k = 0; k < 4; ++k) *reinterpret_cast<u32x4*>(sW + pr * SPLD + qc + k * 8) = *reinterpret_cast<const u32x4*>(src + k * 8);
      }
      {
        const int q = t & 127, eb = (t >> 7) * 32;
        const bf16* vr = Z + (size_t)(r0 + q) * 2048 + 1024 + g * 128 + eb;
        const float mu = sMu[q], rs = sRs[q];
        const float* gs = p.g_sgu + j * 1024 + g * 128 + eb;
        const float* bs = p.b_sgu + j * 1024 + g * 128 + eb;
#pragma unroll
        for (int k = 0; k < 4; ++k) {
          const u32x4 a = *reinterpret_cast<const u32x4*>(vr + k * 8);
#pragma unroll
          for (int m = 0; m < 4; ++m) {
            const int e = k * 8 + 2 * m;
            const float v0 = (bf_lo(a[m]) - mu) * rs * gs[e] + bs[e], v1 = (bf_hi(a[m]) - mu) * rs * gs[e + 1] + bs[e + 1];
            sV[SVROW(eb + e) * SPLD + q] = __float2bfloat16(v0); sV[SVROW(eb + e + 1) * SPLD + q] = __float2bfloat16(v1);
          }
        }
      }
      __syncthreads();
      f32x4 acc[8];
#pragma unroll
      for (int n = 0; n < 8; ++n) acc[n] = f32x4{0.f, 0.f, 0.f, 0.f};
#pragma unroll
      for (int kk = 0; kk < 4; ++kk) {
        const bf16x8 af = *reinterpret_cast<const bf16x8*>(sW + (wid * 16 + fr) * SPLD + kk * 32 + fq * 8);
#pragma unroll
        for (int n = 0; n < 8; ++n) {
          const bf16x8 bfr = *reinterpret_cast<const bf16x8*>(sV + (n * 16 + fr) * SPLD + kk * 32 + fq * 8);
          acc[n] = __builtin_amdgcn_mfma_f32_16x16x32_bf16(af, bfr, acc[n], 0, 0, 0);
        }
      }
#pragma unroll
      for (int jj = 0; jj < 4; ++jj) {
        const int pp = wid * 16 + fq * 4 + jj;
        const float bsp = p.b_spatial[(size_t)j * 1024 + g * 128 + pp];
        const size_t rowo = (size_t)(r0 + pp);
        const u32x4 u8 = *reinterpret_cast<const u32x4*>(Z + rowo * 2048 + g * 128 + 8 * fr);
        u32x4 w;
#pragma unroll
        for (int n2 = 0; n2 < 4; ++n2)
          w[n2] = cvtpk(bf_lo(u8[n2]) * (acc[2 * n2][jj] + bsp), bf_hi(u8[n2]) * (acc[2 * n2 + 1][jj] + bsp));
        *reinterpret_cast<u32x4*>(Aout + rowo * 1024 + g * 128 + 8 * fr) = w;
      }
    }
    __syncthreads();
  }
}


#define XB_TMO      128
#define XB_XCNT(j)  (256  + 64 * (j))
#define XB_XSUB(j)  (1280 + 64 * (j))
#define XB_XGEN(j)  (2304 + 64 * (j))
#define XB_TOP      3328
#define XB_TOPGEN   3392
#define XCD_BAR_WORDS 3456
#define XB_SPIN_CAP (1u << 18)
#define LAS __attribute__((address_space(3)))
DI unsigned xb_ld(unsigned* p)              { return __hip_atomic_load(p, __ATOMIC_RELAXED, __HIP_MEMORY_SCOPE_AGENT); }
DI unsigned xb_add(unsigned* p, unsigned v) { return __hip_atomic_fetch_add(p, v, __ATOMIC_RELAXED, __HIP_MEMORY_SCOPE_AGENT); }
DI unsigned xb_xcc_id() { return (unsigned)__builtin_amdgcn_s_getreg((3 << 11) | 20) & 0xFu; }
#define XB_SPIN(cond, bar) do { unsigned _sp = 0; while (cond) { __builtin_amdgcn_s_sleep(1); \
    if ((++_sp & 255u) == 0u) { if (xb_ld(&(bar)[XB_TMO])) break; if (_sp > XB_SPIN_CAP) { atomicAdd(&(bar)[XB_TMO], 1u); break; } } } } while (0)
struct XcdBarrier { unsigned* bar; unsigned x; volatile LAS unsigned* st; };
DI XcdBarrier xcd_barrier_post(unsigned* bar, volatile LAS unsigned* st) {
  XcdBarrier b; b.bar = bar; b.x = xb_xcc_id(); b.st = st;
  if (threadIdx.x == 0) (void)xb_add(&bar[XB_XCNT(b.x)], 1u);
  return b;
}
DI void xcd_barrier_complete(unsigned* bar, unsigned x, unsigned& nloc, unsigned& nx) {
  const unsigned G = gridDim.x * gridDim.y * gridDim.z;
  unsigned sum, cnt, mine, sp = 0u;
  for (;;) {
    sum = 0u; cnt = 0u; mine = 0u;
#pragma unroll
    for (unsigned j = 0; j < 16; ++j) { const unsigned c = xb_ld(&bar[XB_XCNT(j)]); sum += c; cnt += (c > 0u) ? 1u : 0u; mine = (j == x) ? c : mine; }
    if (sum == G) break;
    __builtin_amdgcn_s_sleep(1);
    if ((++sp & 255u) == 0u) { if (xb_ld(&bar[XB_TMO])) break; if (sp > XB_SPIN_CAP) { atomicAdd(&bar[XB_TMO], 1u); break; } }
  }
  nloc = mine > 0u ? mine : 1u; nx = cnt > 0u ? cnt : 1u;
}
DI void xcd_barrier(const XcdBarrier& b) {
  asm volatile("s_waitcnt vmcnt(0)" ::: "memory");
  __syncthreads();
  if (threadIdx.x == 0) {
    unsigned* bar = b.bar;
    __builtin_amdgcn_s_waitcnt(0);
    unsigned nloc = b.st[0], nx = b.st[1];
    if (nloc == 0u) { xcd_barrier_complete(bar, b.x, nloc, nx); b.st[0] = nloc; b.st[1] = nx; }
    const unsigned old = xb_add(&bar[XB_XSUB(b.x)], 1u);
    const unsigned gen = old / nloc;
    if (old + 1u == (gen + 1u) * nloc) {
      __builtin_amdgcn_fence(__ATOMIC_RELEASE, "agent");
      asm volatile("s_waitcnt vmcnt(0)" ::: "memory");
      const unsigned og = xb_add(&bar[XB_TOP], 1u);
      const unsigned tg = og / nx;
      if (og + 1u == (tg + 1u) * nx) xb_add(&bar[XB_TOPGEN], 1u);
      else XB_SPIN(xb_ld(&bar[XB_TOPGEN]) == tg, bar);
      __builtin_amdgcn_fence(__ATOMIC_ACQUIRE, "agent");
      xb_add(&bar[XB_XGEN(b.x)], 1u);
      asm volatile("s_waitcnt vmcnt(0)" ::: "memory");
    } else {
      XB_SPIN(xb_ld(&bar[XB_XGEN(b.x)]) == gen, bar);
      __builtin_amdgcn_fence(__ATOMIC_ACQUIRE, "agent");
      asm volatile("s_waitcnt vmcnt(0)" ::: "memory");
    }
  }
  __syncthreads();
}

constexpr int NPHASES = 32;
#ifndef PHMASK
#define PHMASK 0xff
#endif
#define EN(b) ((PHMASK >> (b)) & 1)
constexpr int SHM_BYTES = SHM_GEMM + 16;

struct PhaseDesc {
  int kind, layer, epi, Mt, N, K, ldo, nrows, nq;
  unsigned long long offA, offB, offOut;
  int r_gate, r_wh, r_lh, r_sh, r_sc, r_post;
};
constexpr PhaseDesc make_desc(int ph) {
  PhaseDesc d{};
  if (ph == 0) { d.kind = 0; return d; }
  if (ph == 1) { d.kind = 1; return d; }
  int layer = 0, s = 0;
  if (ph < 10) { layer = 0; s = ph - 2; } else if (ph < 17) { layer = 1; s = ph - 10; } else if (ph < 25) { layer = 2; s = ph - 17; } else { layer = 3; s = ph - 25; }
  const bool is_attn = (layer & 1) == 0;
  const int j = layer >> 1;
  const bool ctx_live = layer < 2;
  const int nrows = ctx_live ? NROWS : NLAT;
  const int mt = NLAT / 256; const int cq = ctx_live ? 4 : 0;
  d.layer = layer; d.nrows = nrows;
  int fs = -1;
  if (is_attn) {
    if (s == 0) { d.kind = 3; d.epi = 1; d.offA = OFF_H; d.offB = OFF_WQKV + (size_t)j * 3072 * 1024 * 2; d.Mt = NLAT / 256; d.nq = 4 * (3072 / 128); d.N = 3072; d.K = 1024; d.offOut = OFF_A; d.ldo = QKVW; }
    else if (s == 1) d.kind = 4;
    else if (s == 2) d.kind = 5;
    else if (s == 3) { d.kind = 3; d.epi = 0; d.offA = OFF_H; d.offB = OFF_WAO + (size_t)j * 1024 * 1024 * 2; d.Mt = mt; d.nq = cq * 8; d.N = 1024; d.K = 1024; d.offOut = OFF_A; d.ldo = 1024; }
    else fs = s - 4;
  } else {
    if (s == 0) { d.kind = 3; d.epi = 3; d.offA = OFF_H; d.offB = OFF_WUV + (size_t)j * 2048 * 1024 * 2; d.Mt = mt; d.nq = cq * 16; d.N = 2048; d.K = 1024; d.offOut = OFF_A; d.ldo = 2048; }
    else if (s == 1) d.kind = 6;
    else if (s == 2) { d.kind = 3; d.epi = 0; d.offA = OFF_B; d.offB = OFF_WCO + (size_t)j * 1024 * 1024 * 2; d.Mt = mt; d.nq = cq * 8; d.N = 1024; d.K = 1024; d.offOut = OFF_A; d.ldo = 1024; }
    else fs = s - 3;
  }
  if (fs == 0) { d.kind = 2; d.offA = OFF_A; d.r_gate = 2048; d.r_post = 0; d.r_wh = 1; d.r_lh = layer; d.r_sh = 3072; d.r_sc = 4096; }
  else if (fs == 1) { d.kind = 3; d.epi = 2; d.offA = OFF_H; d.offB = OFF_WFI + (size_t)layer * 5632 * 1024 * 2; d.Mt = mt; d.nq = cq * 44; d.N = 5632; d.K = 1024; d.offOut = OFF_A; d.ldo = FH; }
  else if (fs == 2) { d.kind = 3; d.epi = 0; d.offA = OFF_A; d.offB = OFF_WFO + (size_t)layer * 1024 * 2816 * 2; d.Mt = mt; d.nq = cq * 8; d.N = 1024; d.K = 2816; d.offOut = OFF_B; d.ldo = 1024; }
  else if (fs == 3) { d.kind = 2; d.offA = OFF_B; d.r_gate = 5120; d.r_post = 1; d.r_wh = layer < 3 ? 1 : 0; d.r_lh = layer < 3 ? layer + 1 : 0; d.r_sh = 0; d.r_sc = 1024; }
  return d;
}
struct PhaseTable { PhaseDesc d[NPHASES]; };
constexpr PhaseTable make_table() { PhaseTable t{}; for (int i = 0; i < NPHASES; ++i) t.d[i] = make_desc(i); return t; }
__constant__ PhaseTable g_phases = make_table();

DI void run_phase(const Params& p, int ph, char* lds) {
  const PhaseDesc& d = g_phases.d[ph];
  const int kind = d.kind, layer = d.layer;
  switch (kind) {
    case 2: if (EN(2)) phase_rowwise<false>(layer == 0 && d.r_post == 0, p, d.nrows, (const bf16*)(p.ws + d.offA), layer, d.r_gate, (d.r_post ? p.g_ffn_post : p.g_mix_post) + layer * 1024, d.r_wh != 0,
                                            (d.r_post ? p.g_mix_pre : p.g_ffn_pre) + d.r_lh * 1024, d.r_lh, d.r_sh, d.r_sc); break;
    case 3: if (EN(3)) { EpiArgs ea{(bf16*)(p.ws + d.offOut), d.ldo, p.b_uv + (layer >> 1) * 2048, (const float2*)(p.ws + OFF_ROPE)};
              gemm_phase(d.epi, (const bf16*)(p.ws + d.offA), (const bf16*)(p.ws + d.offB), d.Mt, d.N, d.K, d.nq, ea, lds); } break;
    case 4: if (EN(4)) phase_attention(p, layer < 2, lds); break;
    case 5: if (EN(5)) phase_attn_finish(p, d.nrows, layer >> 1, layer == 0 ? 0.2f : 0.47071302f); break;
    case 6: if (EN(6)) phase_spatial(p, d.nrows / 128, layer >> 1, lds); break;
    default: break;
  }
}

__global__ void __launch_bounds__(NTHR, 2) mega_kernel(Params p, int ph_lo, int ph_hi) {
  extern __shared__ __attribute__((aligned(16))) char lds[];
  cg::grid_group grid = cg::this_grid();
  const bool full = (ph_lo == 0 && ph_hi == NPHASES);
  unsigned* bar = (unsigned*)(p.ws + OFF_BAR);
  volatile LAS unsigned* st = (volatile LAS unsigned*)(LAS char*)(lds + SHM_GEMM);
  if (full) {
    if (threadIdx.x < 2) st[threadIdx.x] = 0u;
    if (blockIdx.x == 0) for (int i = threadIdx.x; i < XCD_BAR_WORDS; i += NTHR) bar[i] = 0u;
    __syncthreads();
  }
  XcdBarrier xb; xb.bar = bar; xb.x = 0; xb.st = st;
  int ph = ph_lo;
  if (ph == 0 && ph < ph_hi) {
    if (EN(0)) phase_prologue(p, lds);
    ++ph;
    if (ph < ph_hi) { grid.sync(); if (full) xb = xcd_barrier_post(bar, st); }
  }
  if (ph == 1 && ph < ph_hi) {
    if (EN(1)) phase_rowwise<true>(false, p, NROWS, nullptr, 0, 0, nullptr, true, p.g_mix_pre, 0, 0, 1024);
    ++ph;
    if (ph < ph_hi) { if (full) xcd_barrier(xb); else grid.sync(); }
  }
  for (; ph < ph_hi; ++ph) {
    run_phase(p, ph, lds);
    if (ph + 1 < ph_hi) { if (full) xcd_barrier(xb); else grid.sync(); }
  }
}

extern "C" void kernel_launch(void* const* d_in, const int* in_sizes, int n_in, void* d_out, int out_size, void* d_ws, size_t ws_size, hipStream_t stream) {
  static int grid_blocks = 0;
  if (grid_blocks == 0) {
    if (n_in != 26 || out_size != NLAT * DM || ws_size < WS_END) {
      fprintf(stderr, "kernel_launch: unexpected shapes n_in %d out %d ws %zu (need %zu)\n", n_in, out_size, ws_size, (size_t)WS_END); grid_blocks = -1; return; }
    int dev = 0, cus = 0, per_cu = 0;
    hipGetDevice(&dev);
    hipDeviceGetAttribute(&cus, hipDeviceAttributeMultiprocessorCount, dev);
    if (hipFuncSetAttribute((const void*)mega_kernel, hipFuncAttributeMaxDynamicSharedMemorySize, SHM_BYTES) != hipSuccess) {
      fprintf(stderr, "kernel_launch: hipFuncSetAttribute failed\n"); grid_blocks = -1; return; }
    hipOccupancyMaxActiveBlocksPerMultiprocessor(&per_cu, (const void*)mega_kernel, NTHR, SHM_BYTES);
    if (per_cu < 1) { fprintf(stderr, "kernel_launch: occupancy query says %d blocks/CU\n", per_cu); per_cu = 1; }
    grid_blocks = cus * per_cu;
    (void)hipGetLastError();
  }
  if (grid_blocks < 0) return;
  Params p{};
  const float** pp = (const float**)&p;
  for (int i = 0; i < 26; ++i) pp[i] = (const float*)d_in[i];
  p.out = (float*)d_out; p.ws = (char*)d_ws;
#if SINGLE_LAUNCH
  int lo = 0, hi = NPHASES;
  void* args[] = {&p, &lo, &hi};
  hipError_t e = hipLaunchCooperativeKernel((const void*)mega_kernel, dim3(grid_blocks), dim3(NTHR), args, SHM_BYTES, stream);
  if (e != hipSuccess) fprintf(stderr, "cooperative launch failed: %s (grid %d)\n", hipGetErrorString(e), grid_blocks);
#else
  for (int ph = 0; ph < NPHASES; ++ph) {
    hipLaunchKernelGGL(mega_kernel, dim3(grid_blocks), dim3(NTHR), SHM_BYTES, stream, p, ph, ph + 1);
  }
#endif
}
```
